# Optimizing an MI355X kernel written in HIP

```python
import math
import jax, jax.numpy as jnp
from jax import lax
import numpy as np

D_MODEL = 2048
BATCH = 1
SEQ = 8192
DEPTH = 4

HEAD_DIM = 128
D_MIX = D_MODEL
A_VDIM = 2 * HEAD_DIM
A_HEADS = (D_MIX // 2) // A_VDIM
B_HEADS = (D_MIX // 4) // HEAD_DIM
C_HEADS = (D_MIX // 4) // HEAD_DIM
IDX_HEADS = 16
IDX_DIM = 128
D_FF = 4 * D_MODEL
N_BUCKETS = 32
MAX_DISTANCE = 128
N_BIAS_HEADS = A_HEADS + C_HEADS
TOPK_CAP = 256
Q_BLOCK = 128
ALPHA = (2 * DEPTH) ** 0.25
INIT_BETA = (8 * DEPTH) ** -0.25
LN_EPS = 1e-5
RMS_EPS = 1e-5
NEG_INF = -1e30

SPLIT_SIZES = [
    A_HEADS * 2 * HEAD_DIM,
    A_HEADS * 2 * HEAD_DIM,
    A_HEADS * A_VDIM,
    B_HEADS * HEAD_DIM,
    B_HEADS * HEAD_DIM,
    B_HEADS * HEAD_DIM,
    C_HEADS * HEAD_DIM,
    C_HEADS * HEAD_DIM,
    C_HEADS * HEAD_DIM,
    IDX_HEADS * IDX_DIM,
    IDX_DIM,
    IDX_HEADS,
]
N_IN = sum(SPLIT_SIZES)
SPLIT_POINTS = [int(v) for v in np.cumsum(SPLIT_SIZES)[:-1]]

kernel_name = 'hybrid_diff_stickbreak_dsa_deepnorm'


def layer_norm(x, g, b):
    xf = x.astype(jnp.float32)
    mu = jnp.mean(xf, -1, keepdims=True)
    var = jnp.mean(jnp.square(xf - mu), -1, keepdims=True)
    y = (xf - mu) * lax.rsqrt(var + LN_EPS) * g.astype(jnp.float32) + b.astype(jnp.float32)
    return y.astype(x.dtype)


def rms_norm(x, g):
    xf = x.astype(jnp.float32)
    y = xf * lax.rsqrt(jnp.mean(xf * xf, -1, keepdims=True) + RMS_EPS) * g.astype(jnp.float32)
    return y.astype(x.dtype)


def rel_bucket(dist):
    n = jnp.maximum(dist, 0)
    max_exact = N_BUCKETS // 2
    nf = jnp.maximum(n, 1).astype(jnp.float32)
    large = max_exact + (jnp.log(nf / max_exact) / math.log(MAX_DISTANCE / max_exact)
                         * (N_BUCKETS - max_exact)).astype(jnp.int32)
    large = jnp.minimum(large, N_BUCKETS - 1)
    return jnp.where(n < max_exact, n, large)


def to_blocks(t):
    b, s = t.shape[0], t.shape[1]
    t = t.reshape((b, s // Q_BLOCK, Q_BLOCK) + t.shape[2:])
    return jnp.moveaxis(t, 1, 0)


def from_blocks(t):
    t = jnp.moveaxis(t, 0, 1)
    return t.reshape((t.shape[0], t.shape[1] * t.shape[2]) + t.shape[3:])


def diff_attention(q, k, v, lam, bias_table):
    s_len = k.shape[1]
    k_pos = jnp.arange(s_len)
    scale = HEAD_DIM ** -0.5
    v32 = v.astype(jnp.float32)
    table = bias_table.astype(jnp.float32)

    def block(args):
        qb, start = args
        q_pos = start + jnp.arange(Q_BLOCK)
        dist = q_pos[:, None] - k_pos[None, :]
        bias = jnp.moveaxis(table[rel_bucket(dist)], -1, 0)
        s = jnp.einsum('bqhmd,bkhmd->bhmqk', qb, k).astype(jnp.float32) * scale
        s = s + bias[None, :, None]
        s = jnp.where((dist >= 0)[None, None, None], s, NEG_INF)
        p = jax.nn.softmax(s, axis=-1)
        p_diff = p[:, :, 0] - lam * p[:, :, 1]
        return jnp.einsum('bhqk,bkhe->bqhe', p_diff, v32).astype(v.dtype)

    starts = jnp.arange(s_len // Q_BLOCK) * Q_BLOCK
    return from_blocks(lax.map(block, (to_blocks(q), starts)))


def stick_breaking_attention(q, k, v):
    s_len = k.shape[1]
    k_pos = jnp.arange(s_len)
    scale = HEAD_DIM ** -0.5
    v32 = v.astype(jnp.float32)

    def block(args):
        qb, start = args
        q_pos = start + jnp.arange(Q_BLOCK)
        strict = (q_pos[:, None] > k_pos[None, :])[None, None]
        z = jnp.einsum('bqhd,bkhd->bhqk', qb, k).astype(jnp.float32) * scale
        log_beta = jax.nn.log_sigmoid(z)
        log_keep = jnp.where(strict, jax.nn.log_sigmoid(-z), 0.0)
        log_after = lax.cumsum(log_keep, axis=3, reverse=True) - log_keep
        a = jnp.where(strict, jnp.exp(log_beta + log_after), 0.0)
        return jnp.einsum('bhqk,bkhd->bqhd', a, v32).astype(v.dtype)

    starts = jnp.arange(s_len // Q_BLOCK) * Q_BLOCK
    return from_blocks(lax.map(block, (to_blocks(q), starts)))


def dsa_attention(q, k, v, q_idx, k_idx, w_idx, bias_table, top_k):
    s_len = k.shape[1]
    k_pos = jnp.arange(s_len)
    scale = HEAD_DIM ** -0.5
    table = bias_table.astype(jnp.float32)
    gather = jax.vmap(lambda arr, ids: arr[ids])

    def block(args):
        qb, qib, wb, start = args
        q_pos = start + jnp.arange(Q_BLOCK)
        causal = q_pos[:, None] >= k_pos[None, :]
        idx_logits = jnp.einsum('bqhd,bkd->bqhk', qib, k_idx).astype(jnp.float32)
        score = jnp.einsum('bqhk,bqh->bqk', jax.nn.relu(idx_logits), wb.astype(jnp.float32))
        score = jnp.where(causal[None], score, -jnp.inf)
        _, sel = lax.top_k(score, top_k)
        k_sel = gather(k, sel)
        v_sel = gather(v, sel).astype(jnp.float32)
        dist = q_pos[None, :, None] - sel
        bias = jnp.transpose(table[rel_bucket(dist)], (0, 3, 1, 2))
        s = jnp.einsum('bqhd,bqkhd->bhqk', qb, k_sel).astype(jnp.float32) * scale + bias
        s = jnp.where((dist >= 0)[:, None], s, NEG_INF)
        p = jax.nn.softmax(s, axis=-1)
        return jnp.einsum('bhqk,bqkhd->bqhd', p, v_sel).astype(v.dtype)

    starts = jnp.arange(s_len // Q_BLOCK) * Q_BLOCK
    return from_blocks(lax.map(block, (to_blocks(q), to_blocks(q_idx), to_blocks(w_idx), starts)))


def hybrid_mixer(x, w_in, w_out, lam_vecs, lam_init, a_g, b_g, c_g, ikn_g, ikn_b, rel_bias):
    b, s, _ = x.shape
    h = x @ w_in
    aq, ak, av, bq, bk, bv, cq, ck, cv, iq, ik, iw = jnp.split(h, SPLIT_POINTS, axis=-1)

    lv = lam_vecs.astype(jnp.float32)
    lam = jnp.exp(jnp.sum(lv[0] * lv[1])) - jnp.exp(jnp.sum(lv[2] * lv[3])) + lam_init
    a_out = diff_attention(aq.reshape(b, s, A_HEADS, 2, HEAD_DIM),
                           ak.reshape(b, s, A_HEADS, 2, HEAD_DIM),
                           av.reshape(b, s, A_HEADS, A_VDIM),
                           lam, rel_bias[:, :A_HEADS])
    a_out = (rms_norm(a_out, a_g) * (1.0 - lam_init)).reshape(b, s, A_HEADS * A_VDIM)

    b_out = stick_breaking_attention(bq.reshape(b, s, B_HEADS, HEAD_DIM),
                                     bk.reshape(b, s, B_HEADS, HEAD_DIM),
                                     bv.reshape(b, s, B_HEADS, HEAD_DIM))
    b_out = rms_norm(b_out.reshape(b, s, B_HEADS * HEAD_DIM), b_g)

    top_k = min(TOPK_CAP, s // 4)
    k_idx = layer_norm(ik, ikn_g, ikn_b)
    w_idx = iw * (IDX_HEADS ** -0.5 * IDX_DIM ** -0.5)
    c_out = dsa_attention(cq.reshape(b, s, C_HEADS, HEAD_DIM),
                          ck.reshape(b, s, C_HEADS, HEAD_DIM),
                          cv.reshape(b, s, C_HEADS, HEAD_DIM),
                          iq.reshape(b, s, IDX_HEADS, IDX_DIM), k_idx, w_idx,
                          rel_bias[:, A_HEADS:], top_k)
    c_out = rms_norm(c_out.reshape(b, s, C_HEADS * HEAD_DIM), c_g)

    mixed = jnp.concatenate([a_out, b_out, c_out], axis=-1)
    return mixed @ w_out


def setup_inputs(seed: int = 0) -> dict:
    key = jax.random.key(seed)
    ks = jax.random.split(key, 16)
    f32 = jnp.float32
    x = jax.random.normal(ks[0], (BATCH, SEQ, D_MODEL), f32)
    w_in = jax.random.normal(ks[1], (DEPTH, D_MODEL, N_IN), f32) * D_MODEL ** -0.5
    w_out = jax.random.normal(ks[2], (DEPTH, D_MIX, D_MODEL), f32) * (D_MIX ** -0.5 * INIT_BETA)
    lam_vecs = jax.random.normal(ks[3], (DEPTH, 4, HEAD_DIM), f32) * 0.1
    a_norm_g = 1.0 + 0.02 * jax.random.normal(ks[4], (DEPTH, A_VDIM), f32)
    b_norm_g = 1.0 + 0.02 * jax.random.normal(ks[5], (DEPTH, B_HEADS * HEAD_DIM), f32)
    c_norm_g = 1.0 + 0.02 * jax.random.normal(ks[6], (DEPTH, C_HEADS * HEAD_DIM), f32)
    idx_k_norm_g = 1.0 + 0.02 * jax.random.normal(ks[7], (DEPTH, IDX_DIM), f32)
    idx_k_norm_b = 0.02 * jax.random.normal(ks[8], (DEPTH, IDX_DIM), f32)
    ln1_g = 1.0 + 0.02 * jax.random.normal(ks[9], (DEPTH, D_MODEL), f32)
    ln1_b = 0.02 * jax.random.normal(ks[10], (DEPTH, D_MODEL), f32)
    w_up = jax.random.normal(ks[11], (DEPTH, D_MODEL, D_FF), f32) * D_MODEL ** -0.5
    w_down = jax.random.normal(ks[12], (DEPTH, D_FF, D_MODEL), f32) * (D_FF ** -0.5 * INIT_BETA)
    ln2_g = 1.0 + 0.02 * jax.random.normal(ks[13], (DEPTH, D_MODEL), f32)
    ln2_b = 0.02 * jax.random.normal(ks[14], (DEPTH, D_MODEL), f32)
    rel_bias = 0.2 * jax.random.normal(ks[15], (N_BUCKETS, N_BIAS_HEADS), f32)
    return {'x': x, 'w_in': w_in, 'w_out': w_out, 'lam_vecs': lam_vecs,
            'a_norm_g': a_norm_g, 'b_norm_g': b_norm_g, 'c_norm_g': c_norm_g,
            'idx_k_norm_g': idx_k_norm_g, 'idx_k_norm_b': idx_k_norm_b,
            'ln1_g': ln1_g, 'ln1_b': ln1_b, 'w_up': w_up, 'w_down': w_down,
            'ln2_g': ln2_g, 'ln2_b': ln2_b, 'rel_bias': rel_bias}


def reference(x, w_in, w_out, lam_vecs, a_norm_g, b_norm_g, c_norm_g, idx_k_norm_g, idx_k_norm_b,
              ln1_g, ln1_b, w_up, w_down, ln2_g, ln2_b, rel_bias):
    for l in range(DEPTH):
        lam_init = 0.8 - 0.6 * math.exp(-0.3 * l)
        m = hybrid_mixer(x, w_in[l], w_out[l], lam_vecs[l], lam_init, a_norm_g[l], b_norm_g[l],
                         c_norm_g[l], idx_k_norm_g[l], idx_k_norm_b[l], rel_bias)
        x = layer_norm(ALPHA * x + m, ln1_g[l], ln1_b[l])
        hdn = jnp.square(jax.nn.relu(x @ w_up[l]))
        x = layer_norm(ALPHA * x + hdn @ w_down[l], ln2_g[l], ln2_b[l])
    return x
```

```cpp
#include <hip/hip_runtime.h>
#include <cstdio>
#include <cstdint>
namespace pg8 {
#define PG8_LAS __attribute__((address_space(3)))
#define PG8_GAS __attribute__((address_space(1)))
typedef unsigned short bf16_t;
typedef short bf16x8 __attribute__((ext_vector_type(8)));
typedef float f32x4 __attribute__((ext_vector_type(4)));
typedef unsigned u32x4 __attribute__((ext_vector_type(4)));
constexpr int BM = 256, BK = 64, HALF = 128, HTB = HALF * BK * 2  , STAGE_BYTES = 8 * HTB, NXCD = 8, WGM = 8;

__host__ __device__ __forceinline__ int lds_byte(int r, int c) { const int st = (r >> 4) * 2 + (c >> 5), rr = r & 15, cc = c & 31, ob = rr * 64 + cc * 2; return st * 1024 + (ob ^ (((ob >> 9) & 1) << 5)); }
__host__ __device__ __forceinline__ void stage_rc(int b, int& R, int& C) { const int st = b / 1024, sb = b % 1024, swz = sb ^ (((sb >> 9) & 1) << 5); R = (st >> 1) * 16 + swz / 64; C = (st & 1) * 32 + (swz % 64) / 2; }
__host__ __device__ __forceinline__ int perm32(int rho) { const int n = rho >> 4, i = rho & 15; return 8 * (i >> 2) + 4 * n + (i & 3); }

struct Unit { int pm, pn; };
struct Gemm { const PG8_GAS bf16_t* A; const PG8_GAS bf16_t* Bt; int M, N, K; };

struct StaticOrder {
    int nM, nN, nwg, G, c;
    __host__ __device__ void init(int M, int N, int G_, int c_) { nM = M / BM; nN = N / BM; nwg = nM * nN; G = G_; c = c_; }
    __host__ __device__ bool next(int i, Unit& u) const {
        const long L = (long)i * G + c; if (L >= nwg) return false;
        int wgid = (int)L; { const int q = nwg / NXCD, r = nwg % NXCD, xcd = wgid % NXCD, off = wgid / NXCD; wgid = (xcd < r ? xcd * (q + 1) : r * (q + 1) + (xcd - r) * q) + off; }
        const int nig = WGM * nN, gid = wgid / nig, fm = gid * WGM, gsz = (nM - fm) < WGM ? (nM - fm) : WGM;
        u.pm = fm + ((wgid % nig) % gsz); u.pn = (wgid % nig) / gsz; return true;
    }
    __device__ __forceinline__ void a_ready(const Unit&) const {}
    __device__ __forceinline__ void done(const Unit&) const {}
};

__device__ __forceinline__ unsigned cvt_pk_bf16(float lo, float hi) { unsigned r; asm volatile("v_cvt_pk_bf16_f32 %0, %1, %2" : "=v"(r) : "v"(lo), "v"(hi)); return r; }
typedef float f32x2 __attribute__((ext_vector_type(2)));
template <class Epi, class Sched, bool ALIGN_EPI = false, bool SP2 = false>
__device__ __forceinline__ void gemm_phase(PG8_LAS unsigned char* lds, const Gemm g, const Sched& S, const Epi& E) {
    int tid_ = threadIdx.x; asm volatile("" : "+v"(tid_));
    const int tid = tid_, wid = __builtin_amdgcn_readfirstlane(tid >> 6), lane = tid & 63, wr = wid >> 2, wc = wid & 3, fr = lane & 15, fq = lane >> 4;
    const int K = g.K, nt = K / BK;
    unsigned voffA[2], voffB[2];
#pragma unroll
    for (int i = 0; i < 2; ++i) { int R, C; stage_rc(tid * 16 + i * 8192, R, C); const int Rb = Epi::PERM ? ((R & ~31) + perm32(R & 31)) : R;
        voffA[i] = (unsigned)(R * K + C) * 2u; voffB[i] = (unsigned)(Rb * K + C) * 2u; }
    const size_t kstep = (size_t)(BK * 2);
    const size_t hstep = (size_t)HALF * K * 2;
    const size_t tstep = 2 * hstep;
    const unsigned ldsw = (unsigned)wid * 1024u;
    const int aoff = lds_byte(wr * 64 + fr, fq * 8), boff = lds_byte(wc * 32 + fr, fq * 8);
#define PG8_SA(b, h) (((b) * 2 + (h)) * HTB)
#define PG8_SB(b, h) ((4 + (b) * 2 + (h)) * HTB)
#define PG8_STAGE(bufoff, gbase, voff) do { _Pragma("unroll") for (int _i = 0; _i < 2; ++_i) \
        __builtin_amdgcn_global_load_lds((const PG8_GAS unsigned*)((const PG8_GAS char*)(gbase) + (voff)[_i]), (PG8_LAS unsigned*)(lds + (bufoff) + ldsw + _i * 8192), 16, 0, 0); } while (0)
#define PG8_LDA(dst, b, h) do { _Pragma("unroll") for (int m = 0; m < 4; ++m) _Pragma("unroll") for (int k = 0; k < 2; ++k) dst[m][k] = *(const PG8_LAS bf16x8*)(lds + PG8_SA(b, h) + aoff + m * 2048 + k * 1024); } while (0)
#define PG8_LDB(dst, b, h) do { _Pragma("unroll") for (int n = 0; n < 2; ++n) _Pragma("unroll") for (int k = 0; k < 2; ++k) dst[n][k] = *(const PG8_LAS bf16x8*)(lds + PG8_SB(b, h) + boff + n * 2048 + k * 1024); } while (0)
#define PG8_MMA(ai, bj, At, Bt) do { __builtin_amdgcn_s_setprio(1); _Pragma("unroll") for (int m = 0; m < 4; ++m) _Pragma("unroll") for (int n = 0; n < 2; ++n) _Pragma("unroll") for (int k = 0; k < 2; ++k) \
        acc[ai][bj][m][n] = __builtin_amdgcn_mfma_f32_16x16x32_bf16(Bt[n][k], At[m][k], acc[ai][bj][m][n], 0, 0, 0); __builtin_amdgcn_s_setprio(0); } while (0)
#define PG8_WAIT_V(n) asm volatile("s_waitcnt vmcnt(" #n ")" ::: "memory")
#define PG8_WAIT_L(n) asm volatile("s_waitcnt lgkmcnt(" #n ")" ::: "memory")
#define PG8_BAR __builtin_amdgcn_s_barrier()
#define PG8_SCHED __builtin_amdgcn_sched_barrier(0)
    Unit cur, nxt; int ui = 0;
    if (!S.next(0, cur)) return;
    f32x4 acc[2][2][4][2];
#pragma unroll
    for (int a = 0; a < 2; ++a)
#pragma unroll
        for (int b = 0; b < 2; ++b)
#pragma unroll
            for (int m = 0; m < 4; ++m)
#pragma unroll
                for (int n = 0; n < 2; ++n) acc[a][b][m][n] = (f32x4){0.f, 0.f, 0.f, 0.f};
    bf16x8 At[4][2], B0[2][2], B1[2][2];
    const PG8_GAS char* cA = (const PG8_GAS char*)g.A + (size_t)cur.pm * tstep; const PG8_GAS char* cB = (const PG8_GAS char*)g.Bt + (size_t)cur.pn * tstep;
    S.a_ready(cur);
    if constexpr (SP2) {
        PG8_STAGE(PG8_SB(0, 0), cB, voffB); PG8_STAGE(PG8_SB(0, 1), cB + hstep, voffB); PG8_STAGE(PG8_SA(0, 0), cA, voffA); PG8_STAGE(PG8_SA(0, 1), cA + hstep, voffA);
        if (wr == 1) PG8_BAR;
        PG8_WAIT_V(2); PG8_BAR;
        PG8_STAGE(PG8_SB(1, 0), cB + kstep, voffB); PG8_STAGE(PG8_SA(1, 0), cA + kstep, voffA); PG8_STAGE(PG8_SB(1, 1), cB + hstep + kstep, voffB);
        PG8_WAIT_V(6); PG8_BAR;
    } else {
        PG8_STAGE(PG8_SB(0, 0), cB, voffB); PG8_STAGE(PG8_SA(0, 0), cA, voffA); PG8_STAGE(PG8_SB(0, 1), cB + hstep, voffB); PG8_STAGE(PG8_SA(0, 1), cA + hstep, voffA);
        if (wr == 1) PG8_BAR;
        PG8_WAIT_V(4); PG8_BAR;
        PG8_STAGE(PG8_SB(1, 0), cB + kstep, voffB); PG8_STAGE(PG8_SA(1, 0), cA + kstep, voffA); PG8_STAGE(PG8_SB(1, 1), cB + hstep + kstep, voffB);
        PG8_WAIT_V(6); PG8_BAR;
    }
    for (;;) {
        const bool has_next = S.next(ui + 1, nxt);
        const PG8_GAS char* nA = has_next ? (const PG8_GAS char*)g.A + (size_t)nxt.pm * tstep : cA; const PG8_GAS char* nB = has_next ? (const PG8_GAS char*)g.Bt + (size_t)nxt.pn * tstep : cB;
        for (int t = 0; t < nt; t += 2) {
            const bool last = (t == nt - 2);
            const PG8_GAS char* a1 = cA + (size_t)(t + 1) * kstep;
            const PG8_GAS char* a2 = last ? nA : cA + (size_t)(t + 2) * kstep; const PG8_GAS char* b2 = last ? nB : cB + (size_t)(t + 2) * kstep;
            const PG8_GAS char* a3 = a2 + kstep; const PG8_GAS char* b3 = b2 + kstep;
            if (last && has_next) S.a_ready(nxt);
            if constexpr (SP2) {
            PG8_LDB(B0, 0, 0); PG8_LDB(B1, 0, 1); PG8_SCHED; PG8_LDA(At, 0, 0); PG8_STAGE(PG8_SA(1, 1), a1 + hstep, voffA);
            PG8_WAIT_V(8); PG8_WAIT_L(0); PG8_BAR; PG8_MMA(0, 0, At, B0); PG8_MMA(0, 1, At, B1); PG8_BAR; PG8_SCHED;
            PG8_LDA(At, 0, 1); PG8_STAGE(PG8_SB(0, 0), b2, voffB); PG8_STAGE(PG8_SB(0, 1), b2 + hstep, voffB); PG8_STAGE(PG8_SA(0, 0), a2, voffA);
            PG8_WAIT_V(8); PG8_WAIT_L(0); PG8_BAR; PG8_MMA(1, 0, At, B0); PG8_MMA(1, 1, At, B1); PG8_BAR; PG8_SCHED;
            PG8_LDB(B0, 1, 0); PG8_LDB(B1, 1, 1); PG8_SCHED; PG8_LDA(At, 1, 0); PG8_STAGE(PG8_SA(0, 1), a2 + hstep, voffA);
            PG8_WAIT_V(8); PG8_WAIT_L(0); PG8_BAR; PG8_MMA(0, 0, At, B0); PG8_MMA(0, 1, At, B1); PG8_BAR; PG8_SCHED;
            PG8_LDA(At, 1, 1); PG8_STAGE(PG8_SB(1, 0), b3, voffB); PG8_STAGE(PG8_SB(1, 1), b3 + hstep, voffB); PG8_STAGE(PG8_SA(1, 0), a3, voffA);
            PG8_WAIT_V(8); PG8_WAIT_L(0); PG8_BAR; PG8_MMA(1, 0, At, B0); PG8_MMA(1, 1, At, B1); PG8_BAR; PG8_SCHED;
            } else {
            PG8_LDB(B0, 0, 0); PG8_SCHED; PG8_LDA(At, 0, 0); PG8_STAGE(PG8_SA(1, 1), a1 + hstep, voffA);
            PG8_WAIT_L(8); PG8_BAR; PG8_WAIT_L(0); PG8_MMA(0, 0, At, B0); PG8_BAR; PG8_SCHED;
            PG8_LDB(B1, 0, 1); PG8_STAGE(PG8_SB(0, 0), b2, voffB);
            PG8_BAR; PG8_WAIT_L(0); PG8_MMA(0, 1, At, B1); PG8_BAR;
            PG8_LDA(At, 0, 1); PG8_STAGE(PG8_SA(0, 0), a2, voffA);
            PG8_BAR; PG8_WAIT_L(0); PG8_MMA(1, 0, At, B0); PG8_BAR; PG8_SCHED;
            PG8_STAGE(PG8_SB(0, 1), b2 + hstep, voffB);
            PG8_WAIT_V(6); PG8_BAR; PG8_MMA(1, 1, At, B1); PG8_BAR;
            PG8_LDB(B0, 1, 0); PG8_SCHED; PG8_LDA(At, 1, 0); PG8_STAGE(PG8_SA(0, 1), a2 + hstep, voffA);
            PG8_WAIT_L(8); PG8_BAR; PG8_WAIT_L(0); PG8_MMA(0, 0, At, B0); PG8_BAR; PG8_SCHED;
            PG8_LDB(B1, 1, 1); PG8_STAGE(PG8_SB(1, 0), b3, voffB);
            PG8_BAR; PG8_WAIT_L(0); PG8_MMA(0, 1, At, B1); PG8_BAR;
            PG8_LDA(At, 1, 1); PG8_STAGE(PG8_SA(1, 0), a3, voffA);
            PG8_BAR; PG8_WAIT_L(0); PG8_MMA(1, 0, At, B0); PG8_BAR; PG8_SCHED;
            PG8_STAGE(PG8_SB(1, 1), b3 + hstep, voffB);
            PG8_WAIT_V(6); PG8_BAR; PG8_MMA(1, 1, At, B1); PG8_BAR;
            }
        }
        if constexpr (ALIGN_EPI) { if (wr == 0) PG8_BAR; }
        if constexpr (!Epi::AFTER_DRAIN) { E(acc, cur, wr, wc, fr, fq); S.done(cur); }
        if (!has_next) break;
#pragma unroll
        for (int a = 0; a < 2; ++a)
#pragma unroll
            for (int b = 0; b < 2; ++b)
#pragma unroll
                for (int m = 0; m < 4; ++m)
#pragma unroll
                    for (int n = 0; n < 2; ++n) acc[a][b][m][n] = (f32x4){0.f, 0.f, 0.f, 0.f};
        cur = nxt; cA = nA; cB = nB; ++ui;
        if constexpr (ALIGN_EPI) { if (wr == 1) PG8_BAR; }
    }
    PG8_WAIT_V(0);
    if constexpr (!ALIGN_EPI) { if (wr == 0) PG8_BAR; }
    PG8_BAR;
    if constexpr (Epi::AFTER_DRAIN) { E.fused(acc, cur, wr, wc, fr, fq, lds, wid, lane); S.done(cur); }
#undef PG8_SA
#undef PG8_SB
#undef PG8_STAGE
#undef PG8_LDA
#undef PG8_LDB
#undef PG8_MMA
#undef PG8_WAIT_V
#undef PG8_WAIT_L
#undef PG8_BAR
#undef PG8_SCHED
}
}
namespace pg8 {
struct EpiInProj {
    static constexpr bool PERM = true, AFTER_DRAIN = false;
    PG8_GAS bf16_t* HQ; PG8_GAS float* TAIL;
    __device__ __forceinline__ void operator()(const f32x4 (&acc)[2][2][4][2], const Unit& u, int wr, int wc, int fr, int fq) const {
        const int row0 = u.pm * BM + wr * 64 + fr, col0 = wc * 32 + 8 * fq;
        if (u.pn < 32) {
#pragma unroll
            for (int ai = 0; ai < 2; ++ai)
#pragma unroll
                for (int m = 0; m < 4; ++m) { PG8_GAS bf16_t* rowp = HQ + (size_t)(row0 + ai * HALF + m * 16) * 8192 + u.pn * BM + col0;
#pragma unroll
                    for (int bj = 0; bj < 2; ++bj) { const f32x4 v0 = acc[ai][bj][m][0], v1 = acc[ai][bj][m][1];
                        u32x4 w; w.x = cvt_pk_bf16(v0[0], v0[1]); w.y = cvt_pk_bf16(v0[2], v0[3]); w.z = cvt_pk_bf16(v1[0], v1[1]); w.w = cvt_pk_bf16(v1[2], v1[3]);
                        *(PG8_GAS u32x4*)(rowp + bj * HALF) = w; } }
        } else {
#pragma unroll
            for (int ai = 0; ai < 2; ++ai)
#pragma unroll
                for (int m = 0; m < 4; ++m) { PG8_GAS float* rowp = TAIL + (size_t)(row0 + ai * HALF + m * 16) * 256 + col0;
#pragma unroll
                    for (int bj = 0; bj < 2; ++bj) { *(PG8_GAS f32x4*)(rowp + bj * HALF) = acc[ai][bj][m][0]; *(PG8_GAS f32x4*)(rowp + bj * HALF + 4) = acc[ai][bj][m][1]; } }
        }
    }
};
struct EpiResF32 {
    static constexpr bool PERM = true, AFTER_DRAIN = false;
    const PG8_GAS float* res; PG8_GAS float* out; int ldc; float alpha;
    __device__ __forceinline__ void operator()(const f32x4 (&acc)[2][2][4][2], const Unit& u, int wr, int wc, int fr, int fq) const {
        const int row0 = u.pm * BM + wr * 64 + fr, col0 = u.pn * BM + wc * 32 + 8 * fq;
#pragma unroll
        for (int ai = 0; ai < 2; ++ai)
#pragma unroll
            for (int m = 0; m < 4; ++m) { const size_t off = (size_t)(row0 + ai * HALF + m * 16) * ldc + col0;
#pragma unroll
                for (int bj = 0; bj < 2; ++bj) { const f32x4 r0 = *(const PG8_GAS f32x4*)(res + off + bj * HALF), r1 = *(const PG8_GAS f32x4*)(res + off + bj * HALF + 4);
                    *(PG8_GAS f32x4*)(out + off + bj * HALF) = r0 * alpha + acc[ai][bj][m][0]; *(PG8_GAS f32x4*)(out + off + bj * HALF + 4) = r1 * alpha + acc[ai][bj][m][1]; }
                asm volatile("" ::: "memory"); }
    }
};
struct EpiRelu2 {
    static constexpr bool PERM = true, AFTER_DRAIN = false;
    PG8_GAS bf16_t* O; int ldc;
    __device__ __forceinline__ void operator()(const f32x4 (&acc)[2][2][4][2], const Unit& u, int wr, int wc, int fr, int fq) const {
        const int row0 = u.pm * BM + wr * 64 + fr, col0 = u.pn * BM + wc * 32 + 8 * fq;
#pragma unroll
        for (int ai = 0; ai < 2; ++ai)
#pragma unroll
            for (int m = 0; m < 4; ++m) { PG8_GAS bf16_t* rowp = O + (size_t)(row0 + ai * HALF + m * 16) * ldc + col0;
#pragma unroll
                for (int bj = 0; bj < 2; ++bj) { f32x4 v0 = acc[ai][bj][m][0], v1 = acc[ai][bj][m][1];
                    v0 = __builtin_elementwise_max(v0, (f32x4){0.f, 0.f, 0.f, 0.f}); v1 = __builtin_elementwise_max(v1, (f32x4){0.f, 0.f, 0.f, 0.f}); v0 = v0 * v0; v1 = v1 * v1;
                    u32x4 w; w.x = cvt_pk_bf16(v0[0], v0[1]); w.y = cvt_pk_bf16(v0[2], v0[3]); w.z = cvt_pk_bf16(v1[0], v1[1]); w.w = cvt_pk_bf16(v1[2], v1[3]);
                    *(PG8_GAS u32x4*)(rowp + bj * HALF) = w; } }
    }
};
}
#define GAS __attribute__((address_space(1)))
#define LAS __attribute__((address_space(3)))
typedef unsigned short bf16;
typedef unsigned v4u __attribute__((ext_vector_type(4)));
typedef float f32x4 __attribute__((ext_vector_type(4)));
typedef short bf16x8 __attribute__((ext_vector_type(8)));
typedef GAS unsigned gu32;
typedef GAS unsigned long long gu64;
#define RLX_AGENT __ATOMIC_RELAXED, __HIP_MEMORY_SCOPE_AGENT
#define LDS_WAIT() asm volatile("s_waitcnt lgkmcnt(0)" ::: "memory")
#define VM_WAIT() asm volatile("s_waitcnt vmcnt(0)" ::: "memory")
__device__ __forceinline__ unsigned long long rt() { return __builtin_amdgcn_s_memrealtime(); }
__device__ __forceinline__ unsigned f2bf(float f) { unsigned u = __builtin_bit_cast(unsigned, f); return (u + 0x7fffu + ((u >> 16) & 1u)) >> 16; }
__device__ __forceinline__ unsigned pk2(float lo, float hi) { return f2bf(lo) | (f2bf(hi) << 16); }

#define XB_TMO      128
#define XB_XCNT(j)  (256  + 64 * (j))
#define XB_XSUB(j)  (1280 + 64 * (j))
#define XB_XGEN(j)  (2304 + 64 * (j))
#define XB_TOP      3328
#define XB_TOPGEN   3392
#define XCD_BAR_WORDS 3456
#define XB_SPIN_CAP (1u << 18)

__device__ __forceinline__ unsigned xb_ld(unsigned* p)              { return __hip_atomic_load(p, __ATOMIC_RELAXED, __HIP_MEMORY_SCOPE_AGENT); }
__device__ __forceinline__ unsigned xb_add(unsigned* p, unsigned v) { return __hip_atomic_fetch_add(p, v, __ATOMIC_RELAXED, __HIP_MEMORY_SCOPE_AGENT); }
__device__ __forceinline__ unsigned xb_xcc_id() { return (unsigned)__builtin_amdgcn_s_getreg((3 << 11) | 20) & 0xFu; }
#define XB_SPIN(cond, bar) do { unsigned _sp = 0; while (cond) { __builtin_amdgcn_s_sleep(1); \
    if ((++_sp & 255u) == 0u) { if (xb_ld(&(bar)[XB_TMO])) break; if (_sp > XB_SPIN_CAP) { atomicAdd(&(bar)[XB_TMO], 1u); break; } } } } while (0)

struct XcdBarrier {
    unsigned* bar; unsigned x;
    volatile LAS unsigned* st;
};

__device__ __forceinline__ XcdBarrier xcd_barrier_post(unsigned* bar, volatile LAS unsigned* st) {
    XcdBarrier b; b.bar = bar; b.x = xb_xcc_id(); b.st = st;
    if (threadIdx.x == 0) (void)xb_add(&bar[XB_XCNT(b.x)], 1u);
    return b;
}
__device__ __forceinline__ void xcd_barrier_complete(unsigned* bar, unsigned x, unsigned& nloc, unsigned& nx) {
    const unsigned G = gridDim.x * gridDim.y * gridDim.z;
    unsigned sum, cnt, mine, sp = 0u;
    for (;;) {
        sum = 0u; cnt = 0u; mine = 0u;
#pragma unroll
        for (unsigned j = 0; j < 16; ++j) { const unsigned c = xb_ld(&bar[XB_XCNT(j)]); sum += c; cnt += (c > 0u) ? 1u : 0u; mine = (j == x) ? c : mine; }
        if (sum == G) break;
        __builtin_amdgcn_s_sleep(1);
        if ((++sp & 255u) == 0u) { if (xb_ld(&bar[XB_TMO])) break; if (sp > XB_SPIN_CAP) { atomicAdd(&bar[XB_TMO], 1u); break; } }
    }
    nloc = mine > 0u ? mine : 1u; nx = cnt > 0u ? cnt : 1u;
}

__device__ __forceinline__ void xcd_barrier(const XcdBarrier& b) {
    asm volatile("s_waitcnt vmcnt(0)" ::: "memory");
    __syncthreads();
    if (threadIdx.x == 0) {
        unsigned* bar = b.bar;
        __builtin_amdgcn_s_waitcnt(0);
        unsigned nloc = b.st[0], nx = b.st[1];
        if (nloc == 0u) { xcd_barrier_complete(bar, b.x, nloc, nx); b.st[0] = nloc; b.st[1] = nx; }
        const unsigned old = xb_add(&bar[XB_XSUB(b.x)], 1u);
        const unsigned gen = old / nloc;
        if (old + 1u == (gen + 1u) * nloc) {
            __builtin_amdgcn_fence(__ATOMIC_RELEASE, "agent");
            asm volatile("s_waitcnt vmcnt(0)" ::: "memory");
            const unsigned og = xb_add(&bar[XB_TOP], 1u);
            const unsigned tg = og / nx;
            if (og + 1u == (tg + 1u) * nx) xb_add(&bar[XB_TOPGEN], 1u);
            else XB_SPIN(xb_ld(&bar[XB_TOPGEN]) == tg, bar);
            __builtin_amdgcn_fence(__ATOMIC_ACQUIRE, "agent");
            xb_add(&bar[XB_XGEN(b.x)], 1u);
            asm volatile("s_waitcnt vmcnt(0)" ::: "memory");
        } else {
            XB_SPIN(xb_ld(&bar[XB_XGEN(b.x)]) == gen, bar);
            __builtin_amdgcn_fence(__ATOMIC_ACQUIRE, "agent");
            asm volatile("s_waitcnt vmcnt(0)" ::: "memory");
        }
    }
    __syncthreads();
}
constexpr int NWAVES = 8;
constexpr int SEQ = 8192, DM = 2048, DEPTH = 4, DFF = 8192, NIN = 8336, NINP = 8448, HQP = 8192;
constexpr int AQ_OFF = 0, AK_OFF = 1024, AV_OFF = 2048, BQ_OFF = 3072, BK_OFF = 3584, BV_OFF = 4096, CQ_OFF = 4608, CK_OFF = 5120, CV_OFF = 5632, IQ_OFF = 6144;
constexpr float ALPHA = 1.6817928305074290f;
constexpr float LN_EPS = 1e-5f, RMS_EPS = 1e-5f;
constexpr float SM_SCALE = 0.08838834764831845f;
constexpr float IDX_WSCALE = 0.022097086912079608f;

constexpr size_t MiB = 1u << 20;
constexpr size_t WS_CTL = 0, CTL_ZERO_BYTES = 1 * MiB;
constexpr size_t WS_BT = 1 * MiB;
constexpr size_t WS_WIN = 2 * MiB, WIN_L = 33 * MiB;
constexpr size_t WS_WOUT = 134 * MiB, WOUT_L = 8 * MiB;
constexpr size_t WS_WUP = 166 * MiB, WUP_L = 32 * MiB;
constexpr size_t WS_WDN = 294 * MiB, WDN_L = 32 * MiB;
constexpr size_t WS_XB = 422 * MiB;
constexpr size_t WS_HQ = 454 * MiB;
constexpr size_t WS_TAIL = 582 * MiB;
constexpr size_t WS_KIDX = 590 * MiB, WS_WIDX = 592 * MiB;
constexpr size_t WS_MASK = 593 * MiB;
constexpr size_t WS_BO = 601 * MiB, WS_CO = 617 * MiB;
constexpr size_t WS_MIXED = 633 * MiB;
constexpr size_t WS_SC = 665 * MiB;
constexpr size_t WS_HID = WS_SC, WS_YPRE = WS_SC + 128 * MiB, WS_AO = WS_SC + 192 * MiB;
constexpr size_t WS_END = 921 * MiB;
constexpr int CW_TMO = 0, CW_CODE = 1;
constexpr int CW_BAR = 4096;
constexpr int CW_Q = 8192;
constexpr int RING_OFF = 0, RING_BYTES = 131072;
constexpr int LDSCTL_OFF = RING_BYTES, MISC_OFF = LDSCTL_OFF + 320;
constexpr int LDS_BYTES = 147456;
__device__ const unsigned char REL_BUCKET[128] = {0, 1, 2, 3, 4, 5, 6, 7, 8, 9, 10, 11, 12, 13, 14, 15, 16, 16, 16, 17, 17, 18, 18, 18, 19, 19, 19, 20, 20, 20, 20, 21, 21, 21, 21, 22, 22, 22, 22, 22, 23, 23, 23, 23, 23, 23, 24, 24, 24, 24, 24, 24, 25, 25, 25, 25, 25, 25, 25, 26, 26, 26, 26, 26, 26, 26, 26, 27, 27, 27, 27, 27, 27, 27, 27, 27, 27, 28, 28, 28, 28, 28, 28, 28, 28, 28, 28, 29, 29, 29, 29, 29, 29, 29, 29, 29, 29, 29, 29, 30, 30, 30, 30, 30, 30, 30, 30, 30, 30, 30, 30, 30, 30, 31, 31, 31, 31, 31, 31, 31, 31, 31, 31, 31, 31, 31, 31, 31};
struct Frame {
    LAS unsigned char* lds;
    volatile LAS unsigned* MISC;
    int vcu, G;
};
__device__ __forceinline__ int vtid() { int t = threadIdx.x; asm volatile("" : "+v"(t)); return t; }
__device__ __forceinline__ int opaque_s(int x) { asm volatile("" : "+s"(x)); return x; }
__device__ __forceinline__ GAS const float* kptr(int k) {
    const volatile __attribute__((address_space(4))) unsigned long long* ka = (const volatile __attribute__((address_space(4))) unsigned long long*)__builtin_amdgcn_kernarg_segment_ptr();
    return (GAS const float*)ka[k];
}
__device__ __forceinline__ float shfl_xor_l(float v, int o, int lane) { return __int_as_float(__builtin_amdgcn_ds_bpermute((lane ^ o) << 2, __float_as_int(v))); }
__device__ __forceinline__ float wave_sum(float v, int lane) {
#pragma unroll
    for (int o = 1; o < 64; o <<= 1) v += shfl_xor_l(v, o, lane);
    return v;
}
__device__ __forceinline__ void p0_transpose_item(GAS const float* W, int K, int Nsrc, int Ndst, GAS bf16* WT, LAS float* scr, int item, int lane) {
    const int nblk = Ndst / 32, kb = item / nblk, nb = item % nblk, k0 = 64 * kb, n0 = 32 * nb;
    const int n = n0 + (lane & 31); const bool ok = n < Nsrc;
#pragma unroll 8
    for (int i = 0; i < 32; ++i) { const int kk = 2 * i + (lane >> 5); scr[kk * 33 + (lane & 31)] = ok ? W[(size_t)(k0 + kk) * Nsrc + n] : 0.f; }
    LDS_WAIT(); asm volatile("" ::: "memory");
    const int c = lane & 7;
#pragma unroll
    for (int j = 0; j < 4; ++j) { const int nn = (lane >> 3) + 8 * j; const LAS float* s = scr + (8 * c) * 33 + nn;
        v4u o; o.x = pk2(s[0 * 33], s[1 * 33]); o.y = pk2(s[2 * 33], s[3 * 33]); o.z = pk2(s[4 * 33], s[5 * 33]); o.w = pk2(s[6 * 33], s[7 * 33]);
        *(GAS v4u*)(WT + (size_t)(n0 + nn) * K + k0 + 8 * c) = o; }
    LDS_WAIT(); asm volatile("" ::: "memory");
}
__device__ __forceinline__ void ln_phase(Frame& F, GAS const float* src, GAS const float* g, GAS const float* b, GAS float* dstf, GAS bf16* dstb) {
    const int tid = vtid(), lane = tid & 63, wave = __builtin_amdgcn_readfirstlane(tid >> 6);
    const int gw = F.vcu * NWAVES + wave, NGW = F.G * NWAVES;
    for (int m = gw; m < SEQ; m += NGW) {
        const GAS f32x4* xr = (const GAS f32x4*)(src + (size_t)m * DM) + lane;
        f32x4 v[8]; float s = 0.f;
#pragma unroll
        for (int j = 0; j < 8; ++j) { v[j] = xr[64 * j]; s += (v[j].x + v[j].y) + (v[j].z + v[j].w); }
        const float mean = wave_sum(s, lane) * (1.f / DM); float s2 = 0.f;
#pragma unroll
        for (int j = 0; j < 8; ++j) { v[j] = v[j] - mean; s2 += (v[j].x * v[j].x + v[j].y * v[j].y) + (v[j].z * v[j].z + v[j].w * v[j].w); }
        const float rstd = 1.f / sqrtf(wave_sum(s2, lane) * (1.f / DM) + LN_EPS);
        GAS f32x4* of = (GAS f32x4*)(dstf + (size_t)m * DM) + lane;
        GAS unsigned long long* ob = (GAS unsigned long long*)(dstb + (size_t)m * DM) + lane;
#pragma unroll
        for (int j = 0; j < 8; ++j) { const f32x4 gg = ((const GAS f32x4*)g)[64 * j + lane], bb = ((const GAS f32x4*)b)[64 * j + lane];
            const f32x4 y = v[j] * rstd * gg + bb; of[64 * j] = y;
            ob[64 * j] = (unsigned long long)pk2(y.x, y.y) | ((unsigned long long)pk2(y.z, y.w) << 32); }
    }
}
namespace att {
typedef short s16x4 __attribute__((ext_vector_type(4)));
typedef float f32x16 __attribute__((ext_vector_type(16)));
typedef unsigned u32x4 __attribute__((ext_vector_type(4)));
constexpr int SHM_K = 16384, SHM_V = 16384;
#define KSWZ(row, colB) ((row) * 256 + ((colB) ^ (((row) & 7) << 4)))
#define SBAR() __builtin_amdgcn_sched_barrier(0)
__device__ __forceinline__ int v_st(int k, int c) { const int kk = (k & ~0xC) | ((k & 4) << 1) | ((k & 8) >> 1); return ((kk >> 3) * 4 + (c >> 5)) * 512 + ((kk & 7) * 32 + (c & 31)) * 2; }
__device__ __forceinline__ int v_rd_base(int lane) { return ((lane & 3) << 3) | (((lane >> 2) & 3) << 6) | (((lane >> 4) & 1) << 5) | (((lane >> 5) & 1) << 8); }
constexpr int v_rd_off(int d0, int ks, int half) { return d0 * 512 + ks * 4096 + half * 2048; }
__device__ __forceinline__ int crow(int r, int hi) { return (r & 3) + 8 * (r >> 2) + 4 * hi; }
__device__ __forceinline__ unsigned cvtpk(float lo, float hi) { unsigned r; asm volatile("v_cvt_pk_bf16_f32 %0, %1, %2" : "=v"(r) : "v"(lo), "v"(hi)); return r; }
__device__ __forceinline__ float pl_other(float x, int hi) {
    auto rr = __builtin_amdgcn_permlane32_swap(__float_as_uint(x), __float_as_uint(x), false, false);
    return __uint_as_float(hi ? rr[0] : rr[1]);
}
__device__ __forceinline__ void qkt(f32x16& p0, f32x16& p1, const LAS char* Kt, int r32, int hi, const bf16x8* qr, float init) {
#pragma unroll
    for (int r = 0; r < 16; ++r) { p0[r] = init; p1[r] = init; }
    const LAS char* kb[4];
#pragma unroll
    for (int dd = 0; dd < 4; ++dd) kb[dd] = Kt + KSWZ(r32, (dd * 16 + hi * 8) * 2);
#pragma unroll
    for (int d0 = 0; d0 < 8; ++d0) { const LAS char* a = kb[d0 & 3] + (d0 >> 2) * 128;
        const bf16x8 b0 = *(const LAS bf16x8*)(a);
        const bf16x8 b1 = *(const LAS bf16x8*)(a + 32 * 256);
        p0 = __builtin_amdgcn_mfma_f32_32x32x16_bf16(b0, qr[d0], p0, 0, 0, 0);
        p1 = __builtin_amdgcn_mfma_f32_32x32x16_bf16(b1, qr[d0], p1, 0, 0, 0); }
}
template <int VOFF>
__device__ __forceinline__ void pv_tile(f32x16* o, int vb0, bf16x8 pa0, bf16x8 pa1, bf16x8 pa2, bf16x8 pa3) {
#define TRRD(dst, off) asm volatile("ds_read_b64_tr_b16 %0, %1 offset:%2" : "=&v"(dst) : "v"(vb0), "i"(off) : "memory")
#define PV_D0(d0) do { s16x4 l0, l1, l2, l3, h0, h1, h2, h3; constexpr int b_ = VOFF + v_rd_off(d0, 0, 0); \
        TRRD(l0, b_); TRRD(h0, b_ + 2048); TRRD(l1, b_ + 4096); TRRD(h1, b_ + 6144); TRRD(l2, b_ + 8192); TRRD(h2, b_ + 10240); TRRD(l3, b_ + 12288); TRRD(h3, b_ + 14336); \
        asm volatile("s_waitcnt lgkmcnt(0)" ::: "memory"); SBAR(); \
        o[d0] = __builtin_amdgcn_mfma_f32_32x32x16_bf16(pa0, (bf16x8){l0[0], l0[1], l0[2], l0[3], h0[0], h0[1], h0[2], h0[3]}, o[d0], 0, 0, 0); \
        o[d0] = __builtin_amdgcn_mfma_f32_32x32x16_bf16(pa1, (bf16x8){l1[0], l1[1], l1[2], l1[3], h1[0], h1[1], h1[2], h1[3]}, o[d0], 0, 0, 0); \
        o[d0] = __builtin_amdgcn_mfma_f32_32x32x16_bf16(pa2, (bf16x8){l2[0], l2[1], l2[2], l2[3], h2[0], h2[1], h2[2], h2[3]}, o[d0], 0, 0, 0); \
        o[d0] = __builtin_amdgcn_mfma_f32_32x32x16_bf16(pa3, (bf16x8){l3[0], l3[1], l3[2], l3[3], h3[0], h3[1], h3[2], h3[3]}, o[d0], 0, 0, 0); } while (0)
    PV_D0(0); PV_D0(1); PV_D0(2); PV_D0(3);
#undef PV_D0
#undef TRRD
}
__device__ __forceinline__ void pack_p(const f32x16& p0, const f32x16& p1, bf16x8& pa0, bf16x8& pa1, bf16x8& pa2, bf16x8& pa3) {
#define PK4(P, B_, OUT) do { unsigned a0 = cvtpk(P[B_+0], P[B_+1]), a1 = cvtpk(P[B_+2], P[B_+3]); \
        unsigned b0 = cvtpk(P[B_+4], P[B_+5]), b1 = cvtpk(P[B_+6], P[B_+7]); \
        auto r0 = __builtin_amdgcn_permlane32_swap(a0, b0, false, false); auto r1 = __builtin_amdgcn_permlane32_swap(a1, b1, false, false); \
        u32x4 w = {r0[0], r1[0], r0[1], r1[1]}; OUT = __builtin_bit_cast(bf16x8, w); } while (0)
    PK4(p0, 0, pa0); PK4(p0, 8, pa1); PK4(p1, 0, pa2); PK4(p1, 8, pa3);
#undef PK4
}

__device__ __forceinline__ void sb_unit(LAS unsigned char* ldsb, GAS const bf16* HQ, GAS float* BO, int h, int qb) {
    int tid_ = threadIdx.x; asm volatile("" : "+v"(tid_));
    const int tid = tid_, wid = __builtin_amdgcn_readfirstlane(tid >> 6), lane = tid & 63, r32 = lane & 31, hi = lane >> 5;
    LAS char* V_lds = (LAS char*)ldsb; LAS char* K_lds = (LAS char*)ldsb + SHM_V;
    volatile LAS unsigned* flags = (volatile LAS unsigned*)(ldsb + SHM_V + SHM_K);
    const int q0 = qb * 256, qlo = q0 + 32 * wid, qpos = qlo + r32;
    bf16x8 qr[8];
    { GAS const bf16* Qp = HQ + (size_t)qpos * HQP + BQ_OFF + h * 128 + hi * 8;
#pragma unroll
      for (int d0 = 0; d0 < 8; ++d0) qr[d0] = *(GAS const bf16x8*)(Qp + d0 * 16); }
    f32x16 o[4];
#pragma unroll
    for (int d = 0; d < 4; ++d)
#pragma unroll
        for (int r = 0; r < 16; ++r) o[d][r] = 0.f;
    float R = 0.f; bool active = true;
    const int sr = tid >> 4, sc = (tid & 15) * 8;
    const int vst0 = v_st(sr, sc), vst1 = v_st(32 + sr, sc), kws = KSWZ(sr, sc * 2);
    const int vb0 = (int)(unsigned)(uintptr_t)V_lds + v_rd_base(lane);
    GAS const bf16* Kh = HQ + BK_OFF + h * 128 + sc; GAS const bf16* Vh = HQ + BV_OFF + h * 128 + sc;
    const int jmax = (q0 + 255) / 64;
    constexpr float L2E = 1.4426950408889634f, LN2 = 0.6931471805599453f;
    for (int j = jmax; j >= 0; --j) {
        const int kb = j * 64;
        const bf16x8 k0 = *(GAS const bf16x8*)(Kh + (size_t)(kb + sr) * HQP), k1 = *(GAS const bf16x8*)(Kh + (size_t)(kb + 32 + sr) * HQP);
        const bf16x8 v0 = *(GAS const bf16x8*)(Vh + (size_t)(kb + sr) * HQP), v1 = *(GAS const bf16x8*)(Vh + (size_t)(kb + 32 + sr) * HQP);
        __syncthreads();
        if (j != jmax) { unsigned any = 0u;
#pragma unroll
            for (int w = 0; w < 8; ++w) any |= flags[w];
            if (any == 0u) break; }
        *(LAS bf16x8*)(K_lds + kws) = k0; *(LAS bf16x8*)(K_lds + kws + 32 * 256) = k1;
        *(LAS bf16x8*)(V_lds + vst0) = v0; *(LAS bf16x8*)(V_lds + vst1) = v1;
        __syncthreads();
        if (active && kb <= qlo + 30) {
            f32x16 p0, p1;
            qkt(p0, p1, K_lds, r32, hi, qr, 0.f);
            const int dq = qpos - kb - 4 * hi;
            f32x16 l0, l1;
#pragma unroll
            for (int r = 0; r < 16; ++r) { const int c = (r & 3) + 8 * (r >> 2);
                { const float z = p0[r] * SM_SCALE; const float sp = fmaxf(z, 0.f) + LN2 * __builtin_amdgcn_logf(1.f + __builtin_amdgcn_exp2f(-fabsf(z) * L2E));
                  const bool ok = (dq - c) >= 1; l0[r] = ok ? -sp : 0.f; p0[r] = ok ? z - sp : -__builtin_inff(); }
                { const float z = p1[r] * SM_SCALE; const float sp = fmaxf(z, 0.f) + LN2 * __builtin_amdgcn_logf(1.f + __builtin_amdgcn_exp2f(-fabsf(z) * L2E));
                  const bool ok = (dq - c - 32) >= 1; l1[r] = ok ? -sp : 0.f; p1[r] = ok ? z - sp : -__builtin_inff(); } }
            float g[8], pg[8];
#pragma unroll
            for (int i = 0; i < 4; ++i) { g[i] = (l0[4 * i] + l0[4 * i + 1]) + (l0[4 * i + 2] + l0[4 * i + 3]); g[4 + i] = (l1[4 * i] + l1[4 * i + 1]) + (l1[4 * i + 2] + l1[4 * i + 3]); }
#pragma unroll
            for (int i = 0; i < 8; ++i) pg[i] = pl_other(g[i], hi);
            float base[8]; float run = R;
#pragma unroll
            for (int i = 7; i >= 0; --i) { const float ghi = hi ? g[i] : pg[i], glo = hi ? pg[i] : g[i];
                const float t_hi = run; run += ghi; const float t_lo = run; run += glo; base[i] = hi ? t_hi : t_lo; }
            R = run;
#pragma unroll
            for (int i = 0; i < 4; ++i) {
                { float la = base[i]; p0[4 * i + 3] = __builtin_amdgcn_exp2f((p0[4 * i + 3] + la) * L2E); la += l0[4 * i + 3]; p0[4 * i + 2] = __builtin_amdgcn_exp2f((p0[4 * i + 2] + la) * L2E); la += l0[4 * i + 2];
                  p0[4 * i + 1] = __builtin_amdgcn_exp2f((p0[4 * i + 1] + la) * L2E); la += l0[4 * i + 1]; p0[4 * i] = __builtin_amdgcn_exp2f((p0[4 * i] + la) * L2E); }
                { float la = base[4 + i]; p1[4 * i + 3] = __builtin_amdgcn_exp2f((p1[4 * i + 3] + la) * L2E); la += l1[4 * i + 3]; p1[4 * i + 2] = __builtin_amdgcn_exp2f((p1[4 * i + 2] + la) * L2E); la += l1[4 * i + 2];
                  p1[4 * i + 1] = __builtin_amdgcn_exp2f((p1[4 * i + 1] + la) * L2E); la += l1[4 * i + 1]; p1[4 * i] = __builtin_amdgcn_exp2f((p1[4 * i] + la) * L2E); } }
            bf16x8 pa0, pa1, pa2, pa3;
            pack_p(p0, p1, pa0, pa1, pa2, pa3); SBAR();
            pv_tile<0>(o, vb0, pa0, pa1, pa2, pa3);
            active = !__all(R < -110.f);
        }
        if (lane == 0) flags[wid] = active ? 1u : 0u;
    }
    GAS float* Ow = BO + (size_t)qlo * 512 + h * 128;
#pragma unroll
    for (int r = 0; r < 16; ++r) { const int orow = crow(r, hi);
#pragma unroll
        for (int d0 = 0; d0 < 4; ++d0) Ow[(size_t)orow * 512 + d0 * 32 + r32] = o[d0][r]; }
    __syncthreads();
}
}
namespace att {
constexpr int FL_LDS_V = 0, FL_LDS_K = 2 * SHM_V, FL_LDS_WS = 2 * SHM_V + 2 * SHM_K, FL_LDS_BT = FL_LDS_WS + NWAVES * 256, FL_LDS_Q = FL_LDS_BT + 8 * 512, FL_LDS_END = FL_LDS_Q + 64;
constexpr float FL_THR = 8.f;
struct FBlock { GAS const bf16* Q; GAS const bf16* K; GAS const bf16* V; GAS float* O; GAS const unsigned long long* mask; int opitch; int P0; int head; };
struct FSeam { bf16x8 qr[8]; bf16x8 st_v0, st_v1, st_k0, st_k1; };

template <bool MASKED>
__device__ __forceinline__ void near_tile(f32x16& p0, f32x16& p1, int dq, const LAS float* bt) {
    const float NEG = -__builtin_inff();
#pragma unroll
    for (int r = 0; r < 16; ++r) { const int c = (r & 3) + 8 * (r >> 2); const int d0 = dq - c, d1 = d0 - 32;
        const float b0 = bt[min(max(d0, 0), 127)], b1 = bt[min(max(d1, 0), 127)];
        p0[r] = d0 >= 0 ? p0[r] + b0 : NEG; p1[r] = d1 >= 0 ? p1[r] + b1 : NEG; }
}
__device__ __forceinline__ void sel_tile(f32x16& p0, f32x16& p1, unsigned long long mw, int hi) {
    const float NEG = -__builtin_inff();
    const unsigned w0 = (unsigned)mw >> (4 * hi), w1 = (unsigned)(mw >> 32) >> (4 * hi);
#pragma unroll
    for (int r = 0; r < 16; ++r) { const int c = (r & 3) + 8 * (r >> 2);
        if (!((w0 >> c) & 1u)) p0[r] = NEG; if (!((w1 >> c) & 1u)) p1[r] = NEG; }
}
__device__ __forceinline__ void partialSM(f32x16& p0, f32x16& p1, float& m_reg, float& mn, float& alpha) {
    float pmax = p0[0];
#pragma unroll
    for (int r = 1; r < 16; ++r) pmax = fmaxf(pmax, p0[r]);
#pragma unroll
    for (int r = 0; r < 16; ++r) pmax = fmaxf(pmax, p1[r]);
    { auto rr = __builtin_amdgcn_permlane32_swap(__float_as_uint(pmax), __float_as_uint(pmax), false, false);
      pmax = fmaxf(__uint_as_float(rr[0]), __uint_as_float(rr[1])); }
    constexpr float C2 = 1.4426950408889634f * SM_SCALE;
    if (__builtin_expect(__all((pmax - m_reg) * SM_SCALE <= FL_THR), 1)) { mn = m_reg; alpha = 1.f; }
    else { mn = fmaxf(m_reg, pmax); alpha = __builtin_amdgcn_exp2f((m_reg - mn) * C2); m_reg = mn; }
    const float mnL = -mn * C2;
#pragma unroll
    for (int r = 0; r < 16; ++r) p0[r] = fmaf(p0[r], C2, mnL);
#pragma unroll
    for (int r = 0; r < 16; ++r) p1[r] = fmaf(p1[r], C2, mnL);
#pragma unroll
    for (int r = 0; r < 16; ++r) p0[r] = __builtin_amdgcn_exp2f(p0[r]);
}
__device__ __forceinline__ void finishSM(f32x16& p0, f32x16& p1, float alpha, float& l_reg, bf16x8& pa0, bf16x8& pa1, bf16x8& pa2, bf16x8& pa3) {
#pragma unroll
    for (int r = 0; r < 16; ++r) p1[r] = __builtin_amdgcn_exp2f(p1[r]);
    float ps = 0;
#pragma unroll
    for (int r = 0; r < 16; ++r) ps += p0[r];
#pragma unroll
    for (int r = 0; r < 16; ++r) ps += p1[r];
    { auto rr = __builtin_amdgcn_permlane32_swap(__float_as_uint(ps), __float_as_uint(ps), false, false);
      ps = __uint_as_float(rr[0]) + __uint_as_float(rr[1]); }
    l_reg = l_reg * alpha + ps;
    pack_p(p0, p1, pa0, pa1, pa2, pa3);
}
#define FL_ROW(p, k0, rr) ((p) + (size_t)((k0) + (rr)) * HQP + sc)
#define FL_VMW() asm volatile("s_waitcnt vmcnt(0)" ::: "memory")
#define FL_VMWN(n) asm volatile("s_waitcnt vmcnt(%0)" :: "i"(n) : "memory")
#define FL_SLOAD(Kp, Vp, k0) do { S.st_v0 = *(GAS const bf16x8*)FL_ROW(Vp, k0, sr); S.st_v1 = *(GAS const bf16x8*)FL_ROW(Vp, k0, 32 + sr); \
                                  S.st_k0 = *(GAS const bf16x8*)FL_ROW(Kp, k0, sr); S.st_k1 = *(GAS const bf16x8*)FL_ROW(Kp, k0, 32 + sr); } while (0)
#define FL_SWRITE_K(bf) do { *(LAS bf16x8*)(K_lds + (bf) * SHM_K + kws) = S.st_k0; *(LAS bf16x8*)(K_lds + (bf) * SHM_K + kws + 32 * 256) = S.st_k1; } while (0)
#define FL_SWRITE_V(bf) do { *(LAS bf16x8*)(V_lds + (bf) * SHM_V + vst0) = S.st_v0; *(LAS bf16x8*)(V_lds + (bf) * SHM_V + vst1) = S.st_v1; } while (0)
__device__ __forceinline__ void flash_prime(const FBlock& cur, LAS unsigned char* ldsb, FSeam& S) {
    const int tid = vtid(), wid = __builtin_amdgcn_readfirstlane(tid >> 6), lane = tid & 63, r32 = lane & 31, hi = lane >> 5;
    const int sr = tid >> 4, sc = (tid & 15) * 8, kws = KSWZ(sr, sc * 2); LAS char* K_lds = (LAS char*)ldsb + FL_LDS_K;
#pragma unroll
    for (int d0 = 0; d0 < 8; ++d0) S.qr[d0] = *(GAS const bf16x8*)(cur.Q + (size_t)(wid * 32 + r32) * HQP + d0 * 16 + hi * 8);
    FL_SLOAD(cur.K, cur.V, 0); FL_VMW(); FL_SWRITE_K(0);
    __syncthreads();
}
template <bool MASKED>
__device__ __forceinline__ void flash_block(const FBlock& cur, const FBlock& nxt, LAS unsigned char* ldsb, FSeam& S, float bfar) {
    const int tid = vtid(), wid = __builtin_amdgcn_readfirstlane(tid >> 6), lane = tid & 63, r32 = lane & 31, hi = lane >> 5;
    const int NT = (cur.P0 + 256) / 64;
    const int qlo = cur.P0 + wid * 32, qm = qlo + r32 - 4 * hi;
    LAS char* V_lds = (LAS char*)ldsb + FL_LDS_V; LAS char* K_lds = (LAS char*)ldsb + FL_LDS_K;
    LAS float* wsl = (LAS float*)(ldsb + FL_LDS_WS) + wid * 64; LAS float* li_l = wsl; LAS float* al_l = wsl + 32;
    const LAS float* bt = (const LAS float*)(ldsb + FL_LDS_BT) + cur.head * 128;
    float m_reg = -1e30f, l_reg = 0.f; f32x16 o[4];
#pragma unroll
    for (int d = 0; d < 4; ++d)
#pragma unroll
        for (int r = 0; r < 16; ++r) o[d][r] = 0.f;
    const int sr = tid >> 4, sc = (tid & 15) * 8, vst0 = v_st(sr, sc), vst1 = v_st(32 + sr, sc), kws = KSWZ(sr, sc * 2);
    const int vb0 = (int)(unsigned)(uintptr_t)V_lds + v_rd_base(lane);
    GAS const bf16* Kh = cur.K; GAS const bf16* Vh = cur.V;
    GAS const unsigned long long* mrow = MASKED ? cur.mask + (size_t)(qlo + r32) * 128 : nullptr;
    unsigned long long mw = 0ull;
#define FL_RESC(a) do { if (__any((a) < 1.f)) { if (hi == 0) al_l[r32] = (a); asm volatile("s_waitcnt lgkmcnt(0)" ::: "memory"); \
                     _Pragma("unroll") for (int d_ = 0; d_ < 4; ++d_) _Pragma("unroll") for (int r = 0; r < 16; ++r) o[d_][r] *= al_l[crow(r, hi)]; } } while (0)
#define FL_KBASE(t) ((t) * 64)
#define FL_NEAR(t) (FL_KBASE(t) + 63 + 113 > qlo)
#define FL_MASKT(P0_, P1_, t) do { if (FL_NEAR(t)) near_tile<MASKED>(P0_, P1_, qm - FL_KBASE(t), bt); if (MASKED) sel_tile(P0_, P1_, mw, hi); } while (0)
#define FL_MLOAD(t) do { if (MASKED) mw = mrow[(t)]; } while (0)
    f32x16 pA0, pA1, pB0, pB1; float mnA, mnB, alA, alB; bf16x8 pa0, pa1, pa2, pa3;
    FL_SWRITE_V(0); SBAR();
    FL_MLOAD(0);
    FL_SLOAD(Kh, Vh, FL_KBASE(1));
    SBAR(); qkt(pA0, pA1, K_lds, r32, hi, S.qr, FL_NEAR(0) ? 0.f : bfar);
    FL_MASKT(pA0, pA1, 0); partialSM(pA0, pA1, m_reg, mnA, alA);
    FL_VMW(); FL_SWRITE_V(1); FL_SWRITE_K(1);
    __syncthreads();
#define FL_HALF_STEP(PX0, PX1, mnX, alX, PY0, PY1, alY, t, KB, VB, SB) do { \
        SBAR(); FL_MLOAD(t); qkt(PX0, PX1, K_lds + (KB) * SHM_K, r32, hi, S.qr, FL_NEAR(t) ? 0.f : bfar); \
        finishSM(PY0, PY1, alY, l_reg, pa0, pa1, pa2, pa3); SBAR(); \
        if ((t) + 1 < NT) { FL_SLOAD(Kh, Vh, FL_KBASE((t) + 1)); SBAR(); } \
        pv_tile<(VB) * SHM_V>(o, vb0, pa0, pa1, pa2, pa3); FL_MASKT(PX0, PX1, (t)); partialSM(PX0, PX1, m_reg, mnX, alX); \
        __syncthreads(); \
        if ((t) + 1 < NT) { FL_VMW(); FL_SWRITE_V(SB); FL_SWRITE_K(SB); } \
        FL_RESC(alX); __syncthreads(); } while (0)
    for (int t = 1; t + 1 < NT; t += 2) {
        FL_HALF_STEP(pB0, pB1, mnB, alB, pA0, pA1, alA, t, 1, 0, 0);
        FL_HALF_STEP(pA0, pA1, mnA, alA, pB0, pB1, alB, t + 1, 0, 1, 1);
    }
    SBAR(); FL_MLOAD(NT - 1); qkt(pB0, pB1, K_lds + SHM_K, r32, hi, S.qr, FL_NEAR(NT - 1) ? 0.f : bfar); SBAR();
    FL_SLOAD(nxt.K, nxt.V, 0); SBAR();
#pragma unroll
    for (int d0 = 0; d0 < 8; ++d0) S.qr[d0] = *(GAS const bf16x8*)(nxt.Q + (size_t)(wid * 32 + r32) * HQP + d0 * 16 + hi * 8);
    SBAR();
    finishSM(pA0, pA1, alA, l_reg, pa0, pa1, pa2, pa3); SBAR();
    pv_tile<0>(o, vb0, pa0, pa1, pa2, pa3);
    FL_MASKT(pB0, pB1, NT - 1); partialSM(pB0, pB1, m_reg, mnB, alB); __syncthreads(); FL_RESC(alB);
    finishSM(pB0, pB1, alB, l_reg, pa0, pa1, pa2, pa3); SBAR(); pv_tile<SHM_V>(o, vb0, pa0, pa1, pa2, pa3);
    SBAR(); FL_VMWN(8); FL_SWRITE_K(0); SBAR();
    if (hi == 0) li_l[r32] = l_reg; asm volatile("s_waitcnt lgkmcnt(0)" ::: "memory");
    float rli[16];
#pragma unroll
    for (int r = 0; r < 16; ++r) rli[r] = __builtin_amdgcn_rcpf(li_l[crow(r, hi)]);
    GAS float* Ow = cur.O + (size_t)(wid * 32) * cur.opitch;
#pragma unroll
    for (int r = 0; r < 16; ++r) { const int orow = crow(r, hi);
#pragma unroll
        for (int d0 = 0; d0 < 4; ++d0) Ow[(size_t)orow * cur.opitch + d0 * 32 + r32] = o[d0][r] * rli[r]; }
    __syncthreads();
#undef FL_RESC
#undef FL_KBASE
#undef FL_NEAR
#undef FL_MASKT
#undef FL_MLOAD
#undef FL_HALF_STEP
}
template <bool WITH_C>
__device__ __forceinline__ FBlock flash_item(int i, GAS const bf16* HQ, GAS float* AO, GAS float* CO, GAS const unsigned long long* MASK) {
    constexpr int PER = WITH_C ? 20 : 16;
    const int qb = 31 - i / PER; int p = i % PER; FBlock b; b.P0 = qb * 256;
    GAS const bf16* rowq = HQ + (size_t)qb * 256 * HQP;
    if (WITH_C && p < 4) { b.Q = rowq + CQ_OFF + p * 128; b.K = HQ + CK_OFF + p * 128; b.V = HQ + CV_OFF + p * 128; b.O = CO + (size_t)qb * 256 * 512 + p * 128; b.opitch = 512; b.head = 4 + p; b.mask = MASK; }
    else { if (WITH_C) p -= 4; const int h = p >> 2, m = (p >> 1) & 1, vh = p & 1;
        b.Q = rowq + AQ_OFF + h * 256 + m * 128; b.K = HQ + AK_OFF + h * 256 + m * 128; b.V = HQ + AV_OFF + h * 256 + vh * 128;
        b.O = AO + (size_t)m * SEQ * 1024 + (size_t)qb * 256 * 1024 + h * 256 + vh * 128; b.opitch = 1024; b.head = h; b.mask = nullptr; }
    return b;
}
__device__ __forceinline__ int q_pull(gu32* head, volatile LAS unsigned* slot) {
    if (threadIdx.x == 0) *slot = __hip_atomic_fetch_add(head, 1u, __ATOMIC_RELAXED, __HIP_MEMORY_SCOPE_AGENT);
    __syncthreads(); const int v = (int)*slot; __syncthreads(); return __builtin_amdgcn_readfirstlane(v);
}
template <bool WITH_C>
__device__ __forceinline__ void flash_phase(LAS unsigned char* ldsb, gu32* qhead, GAS const float* BT, GAS const bf16* HQ, GAS float* AO, GAS float* CO, GAS const unsigned long long* MASK) {
    constexpr int NITEMS = WITH_C ? 640 : 512;
    volatile LAS unsigned* slot = (volatile LAS unsigned*)(ldsb + FL_LDS_Q);
    { const int tid = vtid(); LAS float* btl = (LAS float*)(ldsb + FL_LDS_BT);
      for (int u = tid; u < 8 * 128; u += NWAVES * 64) btl[u] = BT[u]; }
    int i = q_pull(qhead, slot);
    if (i >= NITEMS) return;
    FBlock cur = flash_item<WITH_C>(i, HQ, AO, CO, MASK); FSeam S;
    flash_prime(cur, ldsb, S);
    for (;;) {
        const int in = q_pull(qhead, slot); const bool last = in >= NITEMS;
        const FBlock nxt = last ? cur : flash_item<WITH_C>(in, HQ, AO, CO, MASK);
        const float bfar = ((const LAS float*)(ldsb + FL_LDS_BT))[cur.head * 128 + 127];
        if (WITH_C && cur.mask) flash_block<true>(cur, nxt, ldsb, S, bfar); else flash_block<false>(cur, nxt, ldsb, S, bfar);
        if (last) break;
        cur = nxt;
    }
}
#undef FL_ROW
#undef FL_VMW
#undef FL_VMWN
#undef FL_SLOAD
#undef FL_SWRITE_K
#undef FL_SWRITE_V
}
namespace att {
constexpr int IX_LDS_K = 0, IX_LDS_H = 2 * SHM_K, IX_HIST_BYTES = 8192;
__device__ __forceinline__ unsigned shfl_u(unsigned v, int src) { return (unsigned)__builtin_amdgcn_ds_bpermute(src << 2, (int)v); }
__device__ __forceinline__ unsigned suffix_excl(unsigned v, int lane) {
    unsigned s = v;
#pragma unroll
    for (int o = 1; o < 64; o <<= 1) { const unsigned t = shfl_u(s, lane + o); s += (lane + o < 64) ? t : 0u; }
    return s - v;
}
template <int MSH, int DSH>
__device__ __forceinline__ unsigned hist_pass(const unsigned (&key)[128], int ngrp, unsigned pref, unsigned& need, LAS unsigned* hist, int lane) {
    { LAS u32x4* h4 = (LAS u32x4*)hist;
#pragma unroll
      for (int i = 0; i < 8; ++i) h4[i * 64 + lane] = (u32x4){0u, 0u, 0u, 0u}; }
#pragma unroll
    for (int g = 0; g < 4; ++g) if (g < ngrp) {
#pragma unroll
        for (int c = 32 * g; c < 32 * g + 32; ++c) { const unsigned k = key[c];
            const bool m = (MSH >= 32) ? true : ((k >> (MSH & 31)) == pref);
            if (m) { const unsigned d = (k >> DSH) & 0xFFFu; __hip_atomic_fetch_add(hist + (d >> 1), 1u << (16 * (d & 1)), __ATOMIC_RELAXED, __HIP_MEMORY_SCOPE_WORKGROUP); } } }
    asm volatile("s_waitcnt lgkmcnt(0)" ::: "memory");
    unsigned s = 0u;
    { const LAS u32x4* h4 = (const LAS u32x4*)hist + lane * 8;
#pragma unroll
      for (int i = 0; i < 8; ++i) { const u32x4 w = h4[i]; s += (w.x & 0xFFFFu) + (w.x >> 16) + (w.y & 0xFFFFu) + (w.y >> 16) + (w.z & 0xFFFFu) + (w.z >> 16) + (w.w & 0xFFFFu) + (w.w >> 16); } }
    const unsigned above = suffix_excl(s, lane);
    const unsigned long long b1 = __ballot(above < need && need <= above + s);
    const int L1 = (int)__builtin_ctzll(b1 | (1ull << 63));
    need -= (unsigned)__builtin_amdgcn_readlane((int)above, L1);
    const unsigned w = hist[32 * L1 + (lane >> 1)]; const unsigned cnt = (lane & 1) ? (w >> 16) : (w & 0xFFFFu);
    const unsigned above2 = suffix_excl(cnt, lane);
    const unsigned long long b2 = __ballot(above2 < need && need <= above2 + cnt);
    const int L2 = (int)__builtin_ctzll(b2 | (1ull << 63));
    need -= (unsigned)__builtin_amdgcn_readlane((int)above2, L2);
    return (unsigned)(64 * L1 + L2);
}
__device__ __forceinline__ void topk_row(GAS const float* SC, GAS unsigned long long* MASK, int t, LAS unsigned* hist, int lane) {
    GAS unsigned long long* mrow = MASK + (size_t)t * 128;
    const int nwords = ((t | 255) >> 6) + 1;
    if (t < 256) {
        for (int c = 0; c < nwords; ++c) { const unsigned long long w = __ballot(64 * c + lane <= t); if (lane == 0) mrow[c] = w; }
        return;
    }
    GAS const float* row = SC + (size_t)t * SEQ;
    const int ngrp = (t >> 11) + 1;
    unsigned key[128];
#pragma unroll
    for (int g = 0; g < 4; ++g) {
        if (g < ngrp) {
#pragma unroll
            for (int c = 32 * g; c < 32 * g + 32; ++c) { const int idx = 64 * c + lane; const float v = __builtin_nontemporal_load(row + min(idx, t));
                const unsigned u = __float_as_uint(v); const unsigned k = (u & 0x80000000u) ? ~u : (u | 0x80000000u); key[c] = idx <= t ? k : 0u; }
        } else {
#pragma unroll
            for (int c = 32 * g; c < 32 * g + 32; ++c) key[c] = 0u;
        }
    }
    unsigned need = 256u;
    const unsigned p1 = hist_pass<32, 20>(key, ngrp, 0u, need, hist, lane);
    const unsigned p2 = hist_pass<20, 8>(key, ngrp, p1, need, hist, lane);
    const unsigned p12 = (p1 << 12) | p2;
    const unsigned p3 = hist_pass<8, 0>(key, ngrp, p12, need, hist, lane) & 0xFFu;
    const unsigned tau = (p12 << 8) | p3;
    unsigned taken = 0u; const unsigned long long lt = (1ull << lane) - 1ull;
#pragma unroll
    for (int c = 0; c < 128; ++c) if (c < nwords) {
        const unsigned k = key[c]; const bool eq = (k == tau); const unsigned long long beq = __ballot(eq);
        const bool sel = (k > tau) || (eq && (taken + (unsigned)__builtin_popcountll(beq & lt) < need));
        taken += (unsigned)__builtin_popcountll(beq);
        const unsigned long long w = __ballot(sel); if (lane == 0) mrow[c] = w; }
}
__device__ __forceinline__ void idx_unit(LAS unsigned char* ldsb, GAS const bf16* HQ, GAS const bf16* KIDX, GAS const float* WIDX, GAS float* SC, GAS unsigned long long* MASK, int t0) {
    const int tid = vtid(), wid = __builtin_amdgcn_readfirstlane(tid >> 6), lane = tid & 63, r32 = lane & 31, hi = lane >> 5;
    const int rg = wid & 3, kp = wid >> 2;
    LAS char* K_lds = (LAS char*)ldsb + IX_LDS_K;
    bf16x8 af[2][8]; f32x4 wv[2][4];
#pragma unroll
    for (int b = 0; b < 2; ++b) { const int qi = 2 * b + ((r32 >> 2) & 1), hd = (r32 & 3) + 4 * (r32 >> 3);
        GAS const bf16* p = HQ + (size_t)(t0 + 4 * rg + qi) * HQP + IQ_OFF + hd * 128 + hi * 8;
#pragma unroll
        for (int d0 = 0; d0 < 8; ++d0) af[b][d0] = *(GAS const bf16x8*)(p + d0 * 16);
        GAS const f32x4* wp = (GAS const f32x4*)(WIDX + (size_t)(t0 + 4 * rg + 2 * b + hi) * 16);
#pragma unroll
        for (int i = 0; i < 4; ++i) wv[b][i] = wp[i]; }
    const int ntiles = (t0 + 15) / 64 + 1;
    const int sr = tid >> 4, sc = (tid & 15) * 8, kws = KSWZ(sr, sc * 2);
    GAS const bf16* Kg = KIDX + sc;
    bf16x8 st0 = *(GAS const bf16x8*)(Kg + (size_t)sr * 128), st1 = *(GAS const bf16x8*)(Kg + (size_t)(32 + sr) * 128);
    *(LAS bf16x8*)(K_lds + kws) = st0; *(LAS bf16x8*)(K_lds + kws + 32 * 256) = st1;
    __syncthreads();
    GAS float* srow0 = SC + (size_t)(t0 + 4 * rg + hi) * SEQ + 32 * kp + r32;
    for (int j = 0; j < ntiles; ++j) {
        if (j + 1 < ntiles) { st0 = *(GAS const bf16x8*)(Kg + (size_t)((j + 1) * 64 + sr) * 128); st1 = *(GAS const bf16x8*)(Kg + (size_t)((j + 1) * 64 + 32 + sr) * 128); }
        const LAS char* Kt = K_lds + (j & 1) * SHM_K + kp * 32 * 256;
        f32x16 a0, a1;
#pragma unroll
        for (int r = 0; r < 16; ++r) { a0[r] = 0.f; a1[r] = 0.f; }
        const LAS char* kb[4];
#pragma unroll
        for (int dd = 0; dd < 4; ++dd) kb[dd] = Kt + KSWZ(r32, (dd * 16 + hi * 8) * 2);
#pragma unroll
        for (int d0 = 0; d0 < 8; ++d0) { const bf16x8 kf = *(const LAS bf16x8*)(kb[d0 & 3] + (d0 >> 2) * 128);
            a0 = __builtin_amdgcn_mfma_f32_32x32x16_bf16(af[0][d0], kf, a0, 0, 0, 0);
            a1 = __builtin_amdgcn_mfma_f32_32x32x16_bf16(af[1][d0], kf, a1, 0, 0, 0); }
        float s0 = 0.f, s1 = 0.f;
#pragma unroll
        for (int r = 0; r < 16; ++r) { s0 = fmaf(fmaxf(a0[r], 0.f), wv[0][r >> 2][r & 3], s0); s1 = fmaf(fmaxf(a1[r], 0.f), wv[1][r >> 2][r & 3], s1); }
        srow0[j * 64] = s0; srow0[(size_t)2 * SEQ + j * 64] = s1;
        if (j + 1 < ntiles) { LAS char* Kn = K_lds + ((j + 1) & 1) * SHM_K; *(LAS bf16x8*)(Kn + kws) = st0; *(LAS bf16x8*)(Kn + kws + 32 * 256) = st1; }
        __syncthreads();
    }
    asm volatile("s_waitcnt vmcnt(0)" ::: "memory");
    __syncthreads();
    LAS unsigned* hist = (LAS unsigned*)(ldsb + IX_LDS_H + wid * IX_HIST_BYTES);
    topk_row(SC, MASK, t0 + 2 * wid, hist, lane);
    topk_row(SC, MASK, t0 + 2 * wid + 1, hist, lane);
    __syncthreads();
}
}
__device__ __forceinline__ void tail_phase(Frame& F, GAS const float* TAIL, GAS const float* g, GAS const float* b, GAS bf16* KIDX, GAS float* WIDX) {
    const int tid = vtid(), lane = tid & 63, wave = __builtin_amdgcn_readfirstlane(tid >> 6);
    const int gw = F.vcu * NWAVES + wave, NGW = F.G * NWAVES;
    typedef float f32x2v __attribute__((ext_vector_type(2)));
    const f32x2v gg = ((const GAS f32x2v*)g)[lane], bb = ((const GAS f32x2v*)b)[lane];
    for (int m = gw; m < SEQ; m += NGW) {
        GAS const float* row = TAIL + (size_t)m * 256;
        f32x2v x = ((const GAS f32x2v*)row)[lane];
        const float mean = wave_sum(x.x + x.y, lane) * (1.f / 128.f);
        x = x - mean;
        const float rstd = 1.f / sqrtf(wave_sum(x.x * x.x + x.y * x.y, lane) * (1.f / 128.f) + LN_EPS);
        const f32x2v y = x * rstd * gg + bb;
        ((GAS unsigned*)(KIDX + (size_t)m * 128))[lane] = pk2(y.x, y.y);
        if (lane < 16) WIDX[(size_t)m * 16 + lane] = row[128 + lane] * IDX_WSCALE;
    }
}
__device__ __forceinline__ float lam_init_of(int l) { return l == 0 ? 0.2f : l == 1 ? 0.35550907f : l == 2 ? 0.47071302f : 0.55605820f; }
__device__ __forceinline__ float lam_of(Frame& F, GAS const float* lv, int l) {
    const int lane = vtid() & 63;
    typedef float f32x2v __attribute__((ext_vector_type(2)));
    const f32x2v a = ((const GAS f32x2v*)lv)[lane], b = ((const GAS f32x2v*)(lv + 128))[lane], c = ((const GAS f32x2v*)(lv + 256))[lane], d = ((const GAS f32x2v*)(lv + 384))[lane];
    const float s01 = wave_sum(a.x * b.x + a.y * b.y, lane), s23 = wave_sum(c.x * d.x + c.y * d.y, lane);
    return __expf(s01) - __expf(s23) + lam_init_of(l);
}
template <bool HAS_A, bool HAS_C>
__device__ __forceinline__ void mix_phase(Frame& F, GAS const float* AO, GAS const float* BO, GAS const float* CO, GAS const float* ag, GAS const float* bg, GAS const float* cg, float lam, float lam_init, GAS bf16* MIXED) {
    const int tid = vtid(), lane = tid & 63, wave = __builtin_amdgcn_readfirstlane(tid >> 6);
    const int gw = F.vcu * NWAVES + wave, NGW = F.G * NWAVES;
    const f32x4 agv = ((const GAS f32x4*)ag)[lane];
    const f32x4 bg0 = ((const GAS f32x4*)bg)[2 * lane], bg1 = ((const GAS f32x4*)bg)[2 * lane + 1];
    const f32x4 cg0 = ((const GAS f32x4*)cg)[2 * lane], cg1 = ((const GAS f32x4*)cg)[2 * lane + 1];
    const float oml = 1.f - lam_init;
    for (int m = gw; m < SEQ; m += NGW) {
        GAS bf16* mrow = MIXED + (size_t)m * DM;
#pragma unroll
        for (int h = 0; h < 4; ++h) {
            f32x4 d = (f32x4){0.f, 0.f, 0.f, 0.f};
            if (HAS_A) { const f32x4 o0 = ((const GAS f32x4*)(AO + (size_t)m * 1024 + h * 256))[lane], o1 = ((const GAS f32x4*)(AO + (size_t)SEQ * 1024 + (size_t)m * 1024 + h * 256))[lane];
                d = o0 - o1 * lam; }
            const float ss = wave_sum((d.x * d.x + d.y * d.y) + (d.z * d.z + d.w * d.w), lane);
            const float r = oml / sqrtf(ss * (1.f / 256.f) + RMS_EPS);
            const f32x4 y = d * r * agv;
            ((GAS unsigned long long*)(mrow + h * 256))[lane] = (unsigned long long)pk2(y.x, y.y) | ((unsigned long long)pk2(y.z, y.w) << 32);
        }
        { const f32x4 x0 = ((const GAS f32x4*)(BO + (size_t)m * 512))[2 * lane], x1 = ((const GAS f32x4*)(BO + (size_t)m * 512))[2 * lane + 1];
          const float ss = wave_sum(((x0.x * x0.x + x0.y * x0.y) + (x0.z * x0.z + x0.w * x0.w)) + ((x1.x * x1.x + x1.y * x1.y) + (x1.z * x1.z + x1.w * x1.w)), lane);
          const float r = 1.f / sqrtf(ss * (1.f / 512.f) + RMS_EPS);
          const f32x4 y0 = x0 * r * bg0, y1 = x1 * r * bg1; v4u w; w.x = pk2(y0.x, y0.y); w.y = pk2(y0.z, y0.w); w.z = pk2(y1.x, y1.y); w.w = pk2(y1.z, y1.w);
          ((GAS v4u*)(mrow + 1024))[lane] = w; }
        { f32x4 x0 = (f32x4){0.f, 0.f, 0.f, 0.f}, x1 = x0;
          if (HAS_C) { x0 = ((const GAS f32x4*)(CO + (size_t)m * 512))[2 * lane]; x1 = ((const GAS f32x4*)(CO + (size_t)m * 512))[2 * lane + 1]; }
          const float ss = wave_sum(((x0.x * x0.x + x0.y * x0.y) + (x0.z * x0.z + x0.w * x0.w)) + ((x1.x * x1.x + x1.y * x1.y) + (x1.z * x1.z + x1.w * x1.w)), lane);
          const float r = 1.f / sqrtf(ss * (1.f / 512.f) + RMS_EPS);
          const f32x4 y0 = x0 * r * cg0, y1 = x1 * r * cg1; v4u w; w.x = pk2(y0.x, y0.y); w.y = pk2(y0.z, y0.w); w.z = pk2(y1.x, y1.y); w.w = pk2(y1.z, y1.w);
          ((GAS v4u*)(mrow + 1536))[lane] = w; }
    }
}
#ifndef STAGE_A
#define STAGE_A true
#endif
#ifndef STAGE_C
#define STAGE_C true
#endif
enum { IN_X = 0, IN_WIN, IN_WOUT, IN_LAM, IN_AG, IN_BG, IN_CG, IN_IKG, IN_IKB, IN_LN1G, IN_LN1B, IN_WUP, IN_WDN, IN_LN2G, IN_LN2B, IN_RELB, N_INPUTS };
struct Args { const float* in[16]; float* out; unsigned char* ws; };
__global__ void __launch_bounds__(NWAVES * 64, 2) mk_fwd(Args args) {
    extern __shared__ __attribute__((aligned(16))) unsigned char lds[];
    Frame F;
    F.lds = (LAS unsigned char*)lds;
    F.MISC = (volatile LAS unsigned*)(F.lds + MISC_OFF);
    F.G = gridDim.x; { const int bx = blockIdx.x; F.vcu = (F.G % 8 == 0) ? (bx % 8) * (F.G / 8) + bx / 8 : bx; }
    { const int tid = threadIdx.x;
      for (int u = tid; u < (LDS_BYTES - LDSCTL_OFF) / 4; u += NWAVES * 64) ((LAS unsigned*)(F.lds + LDSCTL_OFF))[u] = 0u;
      __syncthreads();
      __syncthreads(); }
    (void)xcd_barrier_post((unsigned*)((GAS unsigned*)(args.ws + WS_CTL) + CW_BAR), F.MISC + 8);
#define GRID_BAR() do { XcdBarrier b_; b_.bar = (unsigned*)((GAS unsigned*)((GAS unsigned char*)INP(17) + WS_CTL) + CW_BAR); b_.x = xb_xcc_id(); b_.st = F.MISC + 8; xcd_barrier(b_); } while (0)
#define INP(k) kptr(k)
#define OPQ(x) opaque_s(x)
#define PHASE_ENV GAS unsigned char* const ws = (GAS unsigned char*)INP(17); const int ll = OPQ(l); (void)ll; (void)ws

    {
        const int l = 0; PHASE_ENV;
        const int tid = vtid(), lane = tid & 63, wave = __builtin_amdgcn_readfirstlane(tid >> 6);
        const int gw = F.vcu * NWAVES + wave, NGW = F.G * NWAVES;
        LAS float* scr = (LAS float*)(F.lds + RING_OFF + wave * 16384);
        constexpr int I_IN = (DM / 64) * (NINP / 32), I_OUT = (DM / 64) * (DM / 32), I_UP = (DM / 64) * (DFF / 32), I_DN = (DFF / 64) * (DM / 32);
        constexpr int I_L = I_IN + I_OUT + I_UP + I_DN;
        for (int it = gw; it < DEPTH * I_L; it += NGW) {
            const int li = it / I_L; int r = it % I_L;
            if (r < I_IN) { p0_transpose_item(INP(IN_WIN) + (size_t)li * DM * NIN, DM, NIN, NINP, (GAS bf16*)(ws + WS_WIN + li * WIN_L), scr, r, lane); continue; } r -= I_IN;
            if (r < I_OUT) { p0_transpose_item(INP(IN_WOUT) + (size_t)li * DM * DM, DM, DM, DM, (GAS bf16*)(ws + WS_WOUT + li * WOUT_L), scr, r, lane); continue; } r -= I_OUT;
            if (r < I_UP) { p0_transpose_item(INP(IN_WUP) + (size_t)li * DM * DFF, DM, DFF, DFF, (GAS bf16*)(ws + WS_WUP + li * WUP_L), scr, r, lane); continue; } r -= I_UP;
            p0_transpose_item(INP(IN_WDN) + (size_t)li * DFF * DM, DFF, DM, DM, (GAS bf16*)(ws + WS_WDN + li * WDN_L), scr, r, lane);
        }
        if (gw == 0) { GAS const float* relb = INP(IN_RELB); GAS float* BT = (GAS float*)(ws + WS_BT);
            for (int u = lane; u < 8 * 128; u += 64) { const int h = u >> 7, d = u & 127; BT[u] = relb[(int)REL_BUCKET[d] * 8 + h] * (1.f / SM_SCALE); } }
        GAS bf16* XB = (GAS bf16*)(ws + WS_XB); GAS const float* xin = INP(IN_X);
        for (int m = gw; m < SEQ; m += NGW) {
            const GAS f32x4* xr = (const GAS f32x4*)(xin + (size_t)m * DM) + lane;
            GAS unsigned long long* ob = (GAS unsigned long long*)(XB + (size_t)m * DM) + lane;
#pragma unroll
            for (int j = 0; j < 8; ++j) { const f32x4 y = xr[64 * j]; ob[64 * j] = (unsigned long long)pk2(y.x, y.y) | ((unsigned long long)pk2(y.z, y.w) << 32); }
        }
    }
    GRID_BAR();

    for (int l = 0; l < DEPTH; ++l) {
        {
            PHASE_ENV;
            pg8::Gemm g{(GAS const bf16*)(ws + WS_XB), (GAS const bf16*)(ws + WS_WIN + ll * WIN_L), SEQ, NINP, DM}; pg8::StaticOrder S; S.init(SEQ, NINP, OPQ(F.G), OPQ((int)blockIdx.x));
            pg8::EpiInProj E{(GAS bf16*)(ws + WS_HQ), (GAS float*)(ws + WS_TAIL)};
            pg8::gemm_phase<pg8::EpiInProj, pg8::StaticOrder, true, true>(F.lds + RING_OFF, g, S, E);
        }
        GRID_BAR();
        {
            PHASE_ENV;
            tail_phase(F, (GAS const float*)(ws + WS_TAIL), INP(IN_IKG) + ll * 128, INP(IN_IKB) + ll * 128, (GAS bf16*)(ws + WS_KIDX), (GAS float*)(ws + WS_WIDX));
            for (int u = OPQ((int)blockIdx.x); u < 128; u += F.G) att::sb_unit(F.lds + RING_OFF, (GAS const bf16*)(ws + WS_HQ), (GAS float*)(ws + WS_BO), u & 3, u >> 2);
        }
        GRID_BAR();
#if STAGE_C
        {
            PHASE_ENV;
            for (int p = OPQ((int)blockIdx.x); p < 256; p += F.G) {
                att::idx_unit(F.lds + RING_OFF, (GAS const bf16*)(ws + WS_HQ), (GAS const bf16*)(ws + WS_KIDX), (GAS const float*)(ws + WS_WIDX), (GAS float*)(ws + WS_SC), (GAS unsigned long long*)(ws + WS_MASK), 16 * p);
                att::idx_unit(F.lds + RING_OFF, (GAS const bf16*)(ws + WS_HQ), (GAS const bf16*)(ws + WS_KIDX), (GAS const float*)(ws + WS_WIDX), (GAS float*)(ws + WS_SC), (GAS unsigned long long*)(ws + WS_MASK), 16 * (511 - p));
            }
        }
        GRID_BAR();
#endif
#if STAGE_A
        {
            PHASE_ENV;
            att::flash_phase<STAGE_C>(F.lds + RING_OFF, (gu32*)(ws + WS_CTL) + CW_Q + 64 * ll, (GAS const float*)(ws + WS_BT), (GAS const bf16*)(ws + WS_HQ), (GAS float*)(ws + WS_AO), (GAS float*)(ws + WS_CO), (GAS const unsigned long long*)(ws + WS_MASK));
        }
        GRID_BAR();
#endif
        {
            PHASE_ENV;
            const float lam = lam_of(F, INP(IN_LAM) + ll * 512, ll);
            mix_phase<STAGE_A, STAGE_C>(F, (GAS const float*)(ws + WS_AO), (GAS const float*)(ws + WS_BO), (GAS const float*)(ws + WS_CO), INP(IN_AG) + ll * 256, INP(IN_BG) + ll * 512, INP(IN_CG) + ll * 512, lam, lam_init_of(ll), (GAS bf16*)(ws + WS_MIXED));
        }
        GRID_BAR();
        {
            PHASE_ENV;
            pg8::Gemm g{(GAS const bf16*)(ws + WS_MIXED), (GAS const bf16*)(ws + WS_WOUT + ll * WOUT_L), SEQ, DM, DM}; pg8::StaticOrder S; S.init(SEQ, DM, OPQ(F.G), OPQ((int)blockIdx.x));
            pg8::EpiResF32 E{ll == 0 ? INP(IN_X) : INP(16), (GAS float*)(ws + WS_YPRE), DM, ALPHA};
            pg8::gemm_phase<pg8::EpiResF32, pg8::StaticOrder, true, true>(F.lds + RING_OFF, g, S, E);
        }
        GRID_BAR();
        { PHASE_ENV; ln_phase(F, (GAS const float*)(ws + WS_YPRE), INP(IN_LN1G) + ll * DM, INP(IN_LN1B) + ll * DM, (GAS float*)INP(16), (GAS bf16*)(ws + WS_XB)); }
        GRID_BAR();
        {
            PHASE_ENV;
            pg8::Gemm g{(GAS const bf16*)(ws + WS_XB), (GAS const bf16*)(ws + WS_WUP + ll * WUP_L), SEQ, DFF, DM}; pg8::StaticOrder S; S.init(SEQ, DFF, OPQ(F.G), OPQ((int)blockIdx.x));
            pg8::EpiRelu2 E{(GAS bf16*)(ws + WS_HID), DFF};
            pg8::gemm_phase<pg8::EpiRelu2, pg8::StaticOrder, true, true>(F.lds + RING_OFF, g, S, E);
        }
        GRID_BAR();
        {
            PHASE_ENV;
            pg8::Gemm g{(GAS const bf16*)(ws + WS_HID), (GAS const bf16*)(ws + WS_WDN + ll * WDN_L), SEQ, DM, DFF}; pg8::StaticOrder S; S.init(SEQ, DM, OPQ(F.G), OPQ((int)blockIdx.x));
            pg8::EpiResF32 E{INP(16), (GAS float*)(ws + WS_YPRE), DM, ALPHA};
            pg8::gemm_phase<pg8::EpiResF32, pg8::StaticOrder, true, true>(F.lds + RING_OFF, g, S, E);
        }
        GRID_BAR();
        { PHASE_ENV; ln_phase(F, (GAS const float*)(ws + WS_YPRE), INP(IN_LN2G) + ll * DM, INP(IN_LN2B) + ll * DM, (GAS float*)INP(16), (GAS bf16*)(ws + WS_XB)); }
        GRID_BAR();
    }
}

extern "C" void kernel_launch(void* const* d_in, const int* in_sizes, int n_in, void* d_out, int out_size, void* d_ws, size_t ws_size, hipStream_t stream) {
    static int grid = 0;
    if (grid == 0) {
        if (n_in != 16 || in_sizes[0] != SEQ * DM || out_size != SEQ * DM || ws_size < WS_END) {
            fprintf(stderr, "kernel_launch: shape/workspace mismatch (n_in %d, in0 %d, out %d, ws %zu need %zu)\n", n_in, n_in > 0 ? in_sizes[0] : -1, out_size, ws_size, (size_t)WS_END); grid = -1; return; }
        int dev = 0, cus = 0, per_cu = 0;
        if (hipGetDevice(&dev) != hipSuccess || hipDeviceGetAttribute(&cus, hipDeviceAttributeMultiprocessorCount, dev) != hipSuccess) { grid = -1; return; }
        if (hipFuncSetAttribute((const void*)mk_fwd, hipFuncAttributeMaxDynamicSharedMemorySize, LDS_BYTES) != hipSuccess) { fprintf(stderr, "kernel_launch: hipFuncSetAttribute failed\n"); grid = -1; return; }
        if (hipOccupancyMaxActiveBlocksPerMultiprocessor(&per_cu, (const void*)mk_fwd, NWAVES * 64, LDS_BYTES) != hipSuccess || per_cu < 1)
            fprintf(stderr, "kernel_launch: note: occupancy query reports %d workgroups per CU\n", per_cu);
        (void)hipGetLastError();
        grid = cus;
    }
    if (grid < 0) return;
    if (hipMemsetAsync((char*)d_ws + WS_CTL, 0, CTL_ZERO_BYTES, stream) != hipSuccess) return;
    Args a{};
    for (int i = 0; i < 16; ++i) a.in[i] = (const float*)d_in[i];
    a.out = (float*)d_out; a.ws = (unsigned char*)d_ws;
    hipLaunchKernelGGL(mk_fwd, dim3(grid), dim3(NWAVES * 64), LDS_BYTES, stream, a);
}
```
